# Optimizing an MI355X kernel written in HIP

```python
import math
import jax
import jax.numpy as jnp
from jax import lax
import numpy as np

D_MODEL = 1024
BATCH = 4
SEQ = 4096
DEPTH = 4

CTX_LEN = 256
GRID_W = 64
EPS = 1e-6

A_HEADS = 4
A_QK = 128
A_V = 256
A_WIDTH = A_HEADS * A_V
A_CHUNK = 64
F_BIAS_LO = 3.0
F_BIAS_HI = 6.0

B_HEADS = 8
B_QK = 64
B_V = 128
B_WIDTH = B_HEADS * B_V
B_QBLOCK = 128
ROPE_AXIS_DIM = B_QK // 2
ROPE_THETA = 10000.0

C_GROUPS = 4
C_GROUP_DIM = 256
C_WIDTH = C_GROUPS * C_GROUP_DIM

N_BRANCH = 3

COL_SIZES = (
    A_HEADS * A_QK, A_HEADS * A_QK, A_WIDTH, 4 * A_HEADS, A_WIDTH, A_WIDTH,
    B_HEADS * 2 * B_QK, B_HEADS * 2 * B_QK, B_WIDTH, B_WIDTH,
    C_WIDTH, C_WIDTH,
    N_BRANCH * D_MODEL,
)
D_IN = 2 * A_HEADS * A_QK + 3 * A_WIDTH + 4 * A_HEADS + 4 * B_HEADS * B_QK + 2 * B_WIDTH + 2 * C_WIDTH + N_BRANCH * D_MODEL

kernel_name = "hybrid_mlstm_diffattn_fourier_prefix_block"


def rmsnorm(x, w):
    xf = x.astype(jnp.float32)
    y = xf * lax.rsqrt(jnp.mean(xf * xf, axis=-1, keepdims=True) + EPS)
    return (y * w.astype(jnp.float32)).astype(x.dtype)


def split_cols(p):
    parts, start = [], 0
    for size in COL_SIZES:
        parts.append(p[..., start:start + size])
        start += size
    return parts


def axial_rope_tables(n_tokens):
    rows = n_tokens // GRID_W
    row = jnp.repeat(jnp.arange(rows, dtype=jnp.float32), GRID_W)
    col = jnp.tile(jnp.arange(GRID_W, dtype=jnp.float32), rows)
    inv_freq = ROPE_THETA ** (-jnp.arange(0, ROPE_AXIS_DIM, 2, dtype=jnp.float32) / ROPE_AXIS_DIM)
    ang_r = row[:, None] * inv_freq
    ang_c = col[:, None] * inv_freq
    ex = lambda t: t[:, None, None, :]
    return (ex(jnp.cos(ang_r)), ex(jnp.sin(ang_r)), ex(jnp.cos(ang_c)), ex(jnp.sin(ang_c)))


def _rotate(x, cos, sin):
    x1, x2 = jnp.split(x, 2, axis=-1)
    return jnp.concatenate([x1 * cos - x2 * sin, x2 * cos + x1 * sin], axis=-1)


def apply_axial_rope(x, rope):
    cos_r, sin_r, cos_c, sin_c = rope
    xr, xc = jnp.split(x.astype(jnp.float32), 2, axis=-1)
    return jnp.concatenate([_rotate(xr, cos_r, sin_r), _rotate(xc, cos_c, sin_c)], axis=-1).astype(x.dtype)


def mlstm_prep(q, k, v, g, b_if):
    bsz, n, _ = q.shape
    heads = lambda t, d: t.astype(jnp.float32).reshape(bsz, n, A_HEADS, d).transpose(0, 2, 1, 3)
    qh = heads(q, A_QK)
    kh = heads(k, A_QK) * (A_QK ** -0.5)
    vh = heads(v, A_V)
    pre = (g.astype(jnp.float32).reshape(bsz, n, 4, A_HEADS)
           + b_if.astype(jnp.float32).reshape(4, A_HEADS)).transpose(2, 0, 3, 1)
    fwd = (pre[0], jax.nn.log_sigmoid(pre[1]))
    bwd = (pre[2], jax.nn.log_sigmoid(pre[3]))
    return qh, kh, vh, (fwd, bwd)


def mlstm_zero_state(bsz):
    return (jnp.zeros((bsz, A_HEADS, A_QK, A_V), jnp.float32),
            jnp.zeros((bsz, A_HEADS, A_QK), jnp.float32),
            jnp.zeros((bsz, A_HEADS), jnp.float32))


def mlstm_scan(q, k, v, ig, lf, state):
    bsz, nh, n, _ = q.shape
    nc = n // A_CHUNK

    def chunks(t):
        return jnp.moveaxis(t.reshape(bsz, nh, nc, A_CHUNK, *t.shape[3:]), 2, 0)

    tril = jnp.tril(jnp.ones((A_CHUNK, A_CHUNK), dtype=bool))

    def body(carry, inp):
        c_st, n_st, m_st = carry
        qc, kc, vc, ic, fc = inp
        b = jnp.cumsum(fc, axis=-1)
        dmat = jnp.where(tril, b[..., :, None] - b[..., None, :] + ic[..., None, :], -jnp.inf)
        inter = b + m_st[..., None]
        m_row = jnp.maximum(jnp.max(dmat, axis=-1), inter)
        a = jnp.exp(dmat - m_row[..., None]) * jnp.einsum('bhtd,bhsd->bhts', qc, kc)
        w_inter = jnp.exp(inter - m_row)
        num = jnp.einsum('bhts,bhsv->bhtv', a, vc) + w_inter[..., None] * jnp.einsum('bhtd,bhdv->bhtv', qc, c_st)
        den = jnp.sum(a, axis=-1) + w_inter * jnp.einsum('bhtd,bhd->bht', qc, n_st)
        h = num / jnp.maximum(jnp.abs(den), jnp.exp(-m_row))[..., None]
        b_last = b[..., -1]
        g = b_last[..., None] - b + ic
        m_new = jnp.maximum(b_last + m_st, jnp.max(g, axis=-1))
        wk = jnp.exp(g - m_new[..., None])
        decay = jnp.exp(b_last + m_st - m_new)
        c_new = decay[..., None, None] * c_st + jnp.einsum('bhsd,bhsv->bhdv', kc * wk[..., None], vc)
        n_new = decay[..., None] * n_st + jnp.einsum('bhs,bhsd->bhd', wk, kc)
        return (c_new, n_new, m_new), h

    state, h = lax.scan(body, state, (chunks(q), chunks(k), chunks(v), chunks(ig), chunks(lf)))
    return jnp.moveaxis(h, 0, 2).reshape(bsz, nh, n, v.shape[-1]), state


def mlstm_direction(q, k, v, ig, lf, state, reverse):
    if reverse:
        h, state = mlstm_scan(jnp.flip(q, 2), jnp.flip(k, 2), jnp.flip(v, 2), jnp.flip(ig, 2), jnp.flip(lf, 2), state)
        return jnp.flip(h, 2), state
    return mlstm_scan(q, k, v, ig, lf, state)


def mlstm_mixer(q, k, v, gates, q_c, k_c, v_c, gates_c):
    h_lat, h_ctx = [], []
    for d, reverse in enumerate((False, True)):
        ig_c, lf_c = gates_c[d]
        ig, lf = gates[d]
        hc_d, st = mlstm_direction(q_c, k_c, v_c, ig_c, lf_c, mlstm_zero_state(q_c.shape[0]), reverse)
        h_d, _ = mlstm_direction(q, k, v, ig, lf, st, reverse)
        h_lat.append(h_d)
        h_ctx.append(hc_d)
    return h_lat[0] + h_lat[1], h_ctx[0] + h_ctx[1]


def mlstm_out(h, o, z, a_norm_w):
    bsz, _, n, _ = h.shape
    hn = rmsnorm(h.transpose(0, 2, 1, 3), a_norm_w.reshape(A_HEADS, A_V)).reshape(bsz, n, A_WIDTH)
    return hn.astype(o.dtype) * jax.nn.sigmoid(o) * jax.nn.silu(z)


def diffattn_prep(q, k, v, q_norm_w, k_norm_w, rope):
    bsz, n, _ = q.shape
    qh = rmsnorm(q.reshape(bsz, n, B_HEADS, 2, B_QK), q_norm_w)
    kh = rmsnorm(k.reshape(bsz, n, B_HEADS, 2, B_QK), k_norm_w)
    if rope is not None:
        qh = apply_axial_rope(qh, rope)
        kh = apply_axial_rope(kh, rope)
    vh = v.reshape(bsz, n, B_HEADS, B_V).transpose(0, 2, 1, 3)
    return qh.transpose(0, 2, 3, 1, 4), kh.transpose(0, 2, 3, 1, 4), vh


def attend(q, k, v, lam):
    s = jnp.einsum('bhmqd,bhmkd->bhmqk', q, k, preferred_element_type=jnp.float32) * (B_QK ** -0.5)
    p = jax.nn.softmax(s, axis=-1)
    w = p[:, :, 0] - lam * p[:, :, 1]
    return jnp.einsum('bhqk,bhkv->bhqv', w.astype(v.dtype), v)


def attend_blocked(q, k, v, lam):
    bsz, nh, nm, n, d = q.shape
    nb = n // B_QBLOCK
    qb = jnp.moveaxis(q.reshape(bsz, nh, nm, nb, B_QBLOCK, d), 3, 0)
    o = lax.map(lambda blk: attend(blk, k, v, lam), qb)
    return jnp.moveaxis(o, 0, 2).reshape(bsz, nh, n, v.shape[-1])


def diffattn_out(o, subln_w, lam_init):
    bsz, _, n, _ = o.shape
    return (rmsnorm(o, subln_w) * (1.0 - lam_init)).transpose(0, 2, 1, 3).reshape(bsz, n, B_WIDTH)


def fourier_mix(u):
    bsz, n, _ = u.shape
    uf = u.astype(jnp.float32).reshape(bsz, n, C_GROUPS, C_GROUP_DIM)
    y = jnp.fft.fft2(uf, axes=(1, 3), norm="ortho").real
    return y.reshape(bsz, n, C_WIDTH).astype(u.dtype)


def merge(y_a, y_b, y_c, mg, w_a_out, w_b_out, w_c_out, w_out):
    g_a, g_b, g_c = jnp.split(jax.nn.sigmoid(mg), N_BRANCH, axis=-1)
    y = g_a * (y_a @ w_a_out) + g_b * (y_b @ w_b_out) + g_c * (y_c @ w_c_out)
    return y @ w_out


def hybrid_layer(x, ctx, sc, sc_ctx, rope, layer_idx, last, norm_w, w_ada, b_ada, w_in, b_if, a_norm_w,
                 q_norm_w, k_norm_w, lambda_q1, lambda_k1, lambda_q2, lambda_k2, subln_w,
                 w_a_out, w_b_out, w_c_out, w_out):
    shift, scale, gate = jnp.split((sc @ w_ada + b_ada)[:, None, :], 3, axis=-1)
    shift_c, scale_c, gate_c = jnp.split(sc_ctx @ w_ada + b_ada, 3)
    h = rmsnorm(x, norm_w) * (1.0 + scale) + shift
    hc = rmsnorm(ctx, norm_w) * (1.0 + scale_c) + shift_c
    aq, ak, av, ag, ao, az, bq, bk, bv, bz, cu, cz, mg = split_cols(h @ w_in)
    aq_c, ak_c, av_c, ag_c, ao_c, az_c, bq_c, bk_c, bv_c, bz_c, cu_c, cz_c, mg_c = split_cols(hc @ w_in)

    qa, ka, va, ga = mlstm_prep(aq, ak, av, ag, b_if)
    qa_c, ka_c, va_c, ga_c = mlstm_prep(aq_c, ak_c, av_c, ag_c, b_if)
    h_a, h_a_c = mlstm_mixer(qa, ka, va, ga, qa_c, ka_c, va_c, ga_c)
    y_a = mlstm_out(h_a, ao, az, a_norm_w)

    lam_init = 0.8 - 0.6 * math.exp(-0.3 * layer_idx)
    f32 = jnp.float32
    lam = (jnp.exp(jnp.sum(lambda_q1.astype(f32) * lambda_k1.astype(f32)))
           - jnp.exp(jnp.sum(lambda_q2.astype(f32) * lambda_k2.astype(f32))) + lam_init)
    qb, kb, vb = diffattn_prep(bq, bk, bv, q_norm_w, k_norm_w, rope)
    qb_c, kb_c, vb_c = diffattn_prep(bq_c, bk_c, bv_c, q_norm_w, k_norm_w, None)
    o_b = attend_blocked(qb, jnp.concatenate([kb_c, kb], axis=3), jnp.concatenate([vb_c, vb], axis=2), lam)
    y_b = diffattn_out(o_b, subln_w, lam_init) * jax.nn.silu(bz)

    y_c = fourier_mix(cu) * jax.nn.silu(cz)

    x = x + gate * merge(y_a, y_b, y_c, mg, w_a_out, w_b_out, w_c_out, w_out)
    if not last:
        y_a_c = mlstm_out(h_a_c, ao_c, az_c, a_norm_w)
        y_b_c = diffattn_out(attend(qb_c, kb_c, vb_c, lam), subln_w, lam_init) * jax.nn.silu(bz_c)
        y_c_c = fourier_mix(cu_c) * jax.nn.silu(cz_c)
        ctx = ctx + gate_c * merge(y_a_c, y_b_c, y_c_c, mg_c, w_a_out, w_b_out, w_c_out, w_out)
    return x, ctx


def setup_inputs(seed: int = 0) -> dict:
    key = jax.random.key(seed)
    ks = jax.random.split(key, 24)
    f32 = jnp.float32
    nrm = lambda k, shape, s: jax.random.normal(k, shape, f32) * s
    f_base = jnp.linspace(F_BIAS_LO, F_BIAS_HI, A_HEADS, dtype=f32)
    zeros_h = jnp.zeros((A_HEADS,), f32)
    b_if = jnp.concatenate([zeros_h, f_base, zeros_h, f_base])[None, :] + nrm(ks[8], (DEPTH, 4 * A_HEADS), 0.1)
    return {
        "x": nrm(ks[0], (BATCH, SEQ, D_MODEL), 1.0),
        "c": nrm(ks[1], (BATCH, D_MODEL), 1.0),
        "ctx": nrm(ks[2], (BATCH, CTX_LEN, D_MODEL), 1.0),
        "c_ctx": nrm(ks[3], (D_MODEL,), 1.0),
        "norm_w": 1.0 + nrm(ks[4], (DEPTH, D_MODEL), 0.02),
        "w_ada": nrm(ks[5], (DEPTH, D_MODEL, 3 * D_MODEL), 0.5 * D_MODEL ** -0.5),
        "b_ada": nrm(ks[6], (DEPTH, 3 * D_MODEL), 0.02),
        "w_in": nrm(ks[7], (DEPTH, D_MODEL, D_IN), D_MODEL ** -0.5),
        "b_if": b_if,
        "a_norm_w": 1.0 + nrm(ks[9], (DEPTH, A_WIDTH), 0.02),
        "q_norm_w": 1.0 + nrm(ks[10], (DEPTH, B_QK), 0.02),
        "k_norm_w": 1.0 + nrm(ks[11], (DEPTH, B_QK), 0.02),
        "lambda_q1": nrm(ks[12], (DEPTH, B_QK), 0.1),
        "lambda_k1": nrm(ks[13], (DEPTH, B_QK), 0.1),
        "lambda_q2": nrm(ks[14], (DEPTH, B_QK), 0.1),
        "lambda_k2": nrm(ks[15], (DEPTH, B_QK), 0.1),
        "subln_w": 1.0 + nrm(ks[16], (DEPTH, B_V), 0.02),
        "w_a_out": nrm(ks[17], (DEPTH, A_WIDTH, D_MODEL), A_WIDTH ** -0.5),
        "w_b_out": nrm(ks[18], (DEPTH, B_WIDTH, D_MODEL), B_WIDTH ** -0.5),
        "w_c_out": nrm(ks[19], (DEPTH, C_WIDTH, D_MODEL), C_WIDTH ** -0.5),
        "w_out": nrm(ks[20], (DEPTH, D_MODEL, D_MODEL), D_MODEL ** -0.5),
    }


def reference(x, c, ctx, c_ctx, norm_w, w_ada, b_ada, w_in, b_if, a_norm_w, q_norm_w, k_norm_w,
              lambda_q1, lambda_k1, lambda_q2, lambda_k2, subln_w, w_a_out, w_b_out, w_c_out, w_out):
    rope = axial_rope_tables(x.shape[1])
    sc = jax.nn.silu(c)
    sc_ctx = jax.nn.silu(c_ctx)
    for l in range(DEPTH):
        x, ctx = hybrid_layer(x, ctx, sc, sc_ctx, rope, l, l == DEPTH - 1,
                              norm_w[l], w_ada[l], b_ada[l], w_in[l], b_if[l], a_norm_w[l],
                              q_norm_w[l], k_norm_w[l], lambda_q1[l], lambda_k1[l], lambda_q2[l], lambda_k2[l],
                              subln_w[l], w_a_out[l], w_b_out[l], w_c_out[l], w_out[l])
    return x
```

```cpp
#include <hip/hip_runtime.h>
#include <hip/hip_cooperative_groups.h>
#include <cstdio>
#include <cstdint>
namespace cg = cooperative_groups;

#define LAS __attribute__((address_space(3)))
typedef unsigned short bf16_t;
typedef short bf16x8 __attribute__((ext_vector_type(8)));
typedef float f32x4 __attribute__((ext_vector_type(4)));
typedef float f32x16 __attribute__((ext_vector_type(16)));
typedef unsigned u32x4 __attribute__((ext_vector_type(4)));
typedef unsigned u32x2 __attribute__((ext_vector_type(2)));

constexpr int NTHREADS = 512;
constexpr int LDS_BYTES = 144 * 1024;
constexpr int NB = 4, SEQ = 4096, CTXL = 256, TB = 4352, NTOK = NB * TB, DM = 1024, DIN = 13328, DEPTH = 4;
constexpr int NNAT = 11264, NTR = 2560;
constexpr float EPS = 1e-6f;
constexpr float LOG2E = 1.4426950408889634f;

constexpr size_t WS_CTL = 0;
constexpr size_t WS_MOD = 65536;
constexpr size_t WS_T2A = 311296;
constexpr size_t WS_T2B = 573440;
constexpr size_t WS_F2T = 835584;
constexpr size_t WS_G2T = 901120;
constexpr size_t WS_T1 = 1048576;
constexpr size_t WS_WNAT = 68157440;
constexpr size_t WS_WTR = 91226112;
constexpr size_t WS_WOUT = 96468992;
constexpr size_t WS_H = 104857600;
constexpr size_t WS_GATES = 140509184;
constexpr size_t WS_CTXS = 141623296;
constexpr size_t WS_AQ = 145817600;
constexpr size_t WS_AK = 163643392;
constexpr size_t WS_AKT = 181469184;
constexpr size_t WS_AVT = 199294976;
constexpr size_t WS_BVT = 234946560;
constexpr size_t WS_AO = 270598144;
constexpr size_t WS_AZ = 306249728;
constexpr size_t WS_BQ = 341901312;
constexpr size_t WS_BK = 377552896;
constexpr size_t WS_BZ = 413204480;
constexpr size_t WS_CU = 448856064;
constexpr size_t WS_CZ = 484507648;
constexpr size_t WS_MG = 520159232;
constexpr size_t WS_HF = 627113984;
constexpr size_t WS_HB = 662765568;
constexpr size_t WS_YMF = WS_HF;
constexpr size_t WS_ZTL = 698417152;
constexpr size_t WS_ZTC = 765526016;
constexpr size_t WS_END = 769720320;

#define XB_TMO      128
#define XB_XCNT(j)  (256  + 64 * (j))
#define XB_XSUB(j)  (1280 + 64 * (j))
#define XB_XGEN(j)  (2304 + 64 * (j))
#define XB_TOP      3328
#define XB_TOPGEN   3392
#define XCD_BAR_WORDS 3456
#define XB_SPIN_CAP (1u << 24)
__device__ __forceinline__ unsigned xb_ld(unsigned* p)              { return __hip_atomic_load(p, __ATOMIC_RELAXED, __HIP_MEMORY_SCOPE_AGENT); }
__device__ __forceinline__ unsigned xb_add(unsigned* p, unsigned v) { return __hip_atomic_fetch_add(p, v, __ATOMIC_RELAXED, __HIP_MEMORY_SCOPE_AGENT); }
__device__ __forceinline__ unsigned xb_xcc_id() { return (unsigned)__builtin_amdgcn_s_getreg((3 << 11) | 20) & 0xFu; }
#define XB_SPIN(cond, bar) do { unsigned _sp = 0; while (cond) { __builtin_amdgcn_s_sleep(1); \
    if ((++_sp & 255u) == 0u) { if (xb_ld(&(bar)[XB_TMO])) break; if (_sp > XB_SPIN_CAP) { atomicAdd(&(bar)[XB_TMO], 1u); break; } } } } while (0)
struct XcdBarrier { unsigned* bar; unsigned x; volatile LAS unsigned* st; };
__device__ __forceinline__ XcdBarrier xcd_barrier_post(unsigned* bar, volatile LAS unsigned* st) {
    XcdBarrier b; b.bar = bar; b.x = xb_xcc_id(); b.st = st;
    if (threadIdx.x == 0) (void)xb_add(&bar[XB_XCNT(b.x)], 1u);
    return b;
}
__device__ __forceinline__ void xcd_barrier_complete(unsigned* bar, unsigned x, unsigned& nloc, unsigned& nx) {
    const unsigned G = gridDim.x * gridDim.y * gridDim.z;
    unsigned sum, cnt, mine, sp = 0u;
    for (;;) {
        sum = 0u; cnt = 0u; mine = 0u;
#pragma unroll
        for (unsigned j = 0; j < 16; ++j) { const unsigned c = xb_ld(&bar[XB_XCNT(j)]); sum += c; cnt += (c > 0u) ? 1u : 0u; mine = (j == x) ? c : mine; }
        if (sum == G) break;
        __builtin_amdgcn_s_sleep(1);
        if ((++sp & 255u) == 0u) { if (xb_ld(&bar[XB_TMO])) break; if (sp > XB_SPIN_CAP) { atomicAdd(&bar[XB_TMO], 1u); break; } }
    }
    nloc = mine > 0u ? mine : 1u; nx = cnt > 0u ? cnt : 1u;
}
__device__ __forceinline__ void xcd_barrier(const XcdBarrier& b) {
    asm volatile("s_waitcnt vmcnt(0)" ::: "memory");
    __syncthreads();
    if (threadIdx.x == 0) {
        unsigned* bar = b.bar;
        __builtin_amdgcn_s_waitcnt(0);
        unsigned nloc = b.st[0], nx = b.st[1];
        if (nloc == 0u) { xcd_barrier_complete(bar, b.x, nloc, nx); b.st[0] = nloc; b.st[1] = nx; }
        const unsigned old = xb_add(&bar[XB_XSUB(b.x)], 1u);
        const unsigned gen = old / nloc;
        if (old + 1u == (gen + 1u) * nloc) {
            __builtin_amdgcn_fence(__ATOMIC_RELEASE, "agent");
            asm volatile("s_waitcnt vmcnt(0)" ::: "memory");
            const unsigned og = xb_add(&bar[XB_TOP], 1u);
            const unsigned tg = og / nx;
            if (og + 1u == (tg + 1u) * nx) xb_add(&bar[XB_TOPGEN], 1u);
            else XB_SPIN(xb_ld(&bar[XB_TOPGEN]) == tg, bar);
            __builtin_amdgcn_fence(__ATOMIC_ACQUIRE, "agent");
            xb_add(&bar[XB_XGEN(b.x)], 1u);
            asm volatile("s_waitcnt vmcnt(0)" ::: "memory");
        } else {
            XB_SPIN(xb_ld(&bar[XB_XGEN(b.x)]) == gen, bar);
            __builtin_amdgcn_fence(__ATOMIC_ACQUIRE, "agent");
            asm volatile("s_waitcnt vmcnt(0)" ::: "memory");
        }
    }
    __syncthreads();
}

__device__ __forceinline__ void publish_add(unsigned* ctr) {
    asm volatile("s_waitcnt vmcnt(0)" ::: "memory");
    __syncthreads();
    if (threadIdx.x == 0) { __builtin_amdgcn_fence(__ATOMIC_RELEASE, "agent"); asm volatile("s_waitcnt vmcnt(0)" ::: "memory"); (void)xb_add(ctr, 1u); }
}
__device__ __forceinline__ void publish_add_wt(unsigned* ctr) {
    asm volatile("s_waitcnt vmcnt(0)" ::: "memory");
    __syncthreads();
    if (threadIdx.x == 0) (void)xb_add(ctr, 1u);
}
__device__ __forceinline__ void wait_count(unsigned* ctr, unsigned need) {
    if (threadIdx.x == 0) { unsigned sp = 0; while (xb_ld(ctr) < need) { __builtin_amdgcn_s_sleep(2); if (++sp > (1u << 26)) break; }
        __builtin_amdgcn_fence(__ATOMIC_ACQUIRE, "agent"); asm volatile("s_waitcnt vmcnt(0)" ::: "memory"); }
    __syncthreads();
}

__device__ __forceinline__ unsigned cvtpk(float lo, float hi) { unsigned r; asm("s_nop 1\n\tv_cvt_pk_bf16_f32 %0, %1, %2" : "=v"(r) : "v"(lo), "v"(hi)); return r; }
__device__ __forceinline__ unsigned cvtpk_m(float lo, float hi) { unsigned r; asm("s_nop 1\n\tv_cvt_pk_bf16_f32 %0, %1, %2\n\ts_nop 1" : "=v"(r) : "v"(lo), "v"(hi)); return r; }
__device__ __forceinline__ float bf_lo(unsigned w) { return __uint_as_float(w << 16); }
__device__ __forceinline__ float bf_hi(unsigned w) { return __uint_as_float(w & 0xffff0000u); }
__device__ __forceinline__ float sigm(float x) { return 1.f / (1.f + __expf(-x)); }
__device__ __forceinline__ float silu(float x) { return x / (1.f + __expf(-x)); }
__device__ __forceinline__ float wave_sum(float v) {
#pragma unroll
    for (int o = 32; o > 0; o >>= 1) v += __shfl_xor(v, o);
    return v;
}
__device__ __forceinline__ float wave_max(float v) {
#pragma unroll
    for (int o = 32; o > 0; o >>= 1) v = fmaxf(v, __shfl_xor(v, o));
    return v;
}

__device__ __forceinline__ int tid_opaque() { int t = threadIdx.x; asm volatile("" : "+v"(t)); return t; }

struct Params {
    const float* in[21];
    float* out;
    unsigned char* ws;
};

constexpr int BM = 256, BK = 64, HALF = 128, HTB = HALF * BK * 2, STAGE_BYTES = 8 * HTB;
__device__ __forceinline__ int lds_byte(int r, int c) { const int st = (r >> 4) * 2 + (c >> 5), rr = r & 15, cc = c & 31, ob = rr * 64 + cc * 2; return st * 1024 + (ob ^ (((ob >> 9) & 1) << 5)); }
__device__ __forceinline__ void stage_rc(int b, int& R, int& C) { const int st = b / 1024, sb = b % 1024, swz = sb ^ (((sb >> 9) & 1) << 5); R = (st >> 1) * 16 + swz / 64; C = (st & 1) * 32 + (swz % 64) / 2; }
__device__ __forceinline__ int perm32(int rho) { const int n = rho >> 4, i = rho & 15; return 8 * (i >> 2) + 4 * n + (i & 3); }

struct Unit { int pm, pn, aux; const char* a; const char* b; };

__device__ __forceinline__ bool tile_order(long L, int nM, int nN, int& pm, int& pn) {
    const int nwg = nM * nN; if (L >= nwg) return false;
    int wgid = (int)L; { const int q = nwg / 8, r = nwg % 8, xcd = wgid % 8, off = wgid / 8; wgid = (xcd < r ? xcd * (q + 1) : r * (q + 1) + (xcd - r) * q) + off; }
    const int nig = 8 * nN, gid = wgid / nig, fm = gid * 8, gsz = (nM - fm) < 8 ? (nM - fm) : 8;
    pm = fm + ((wgid % nig) % gsz); pn = (wgid % nig) / gsz; return true;
}

template <bool ALIGN_EPI = false, bool SP2 = false, class Epi, class Sched>
__device__ __forceinline__ void gemm_phase(LAS unsigned char* lds, const int K, const unsigned lda, const unsigned ldb, const Sched& S, const Epi& E) {
    const int tid = tid_opaque(), wid = __builtin_amdgcn_readfirstlane(tid >> 6), lane = tid & 63, wr = wid >> 2, wc = wid & 3, fr = lane & 15, fq = lane >> 4;
    const int nt = K / BK;
    unsigned voffA[2], voffB[2];
#pragma unroll
    for (int i = 0; i < 2; ++i) { int R, C; stage_rc(tid * 16 + i * 8192, R, C); const int Rb = Epi::PERM ? ((R & ~31) + perm32(R & 31)) : R;
        voffA[i] = (unsigned)R * lda + (unsigned)C * 2u; voffB[i] = (unsigned)Sched::bmap(Rb) * ldb + (unsigned)C * 2u; }
    const size_t kstep = (size_t)(BK * 2);
    const size_t hstepA = (size_t)HALF * lda, hstepB = (size_t)Sched::BHALF_ROWS * ldb;
    const unsigned ldsw = (unsigned)wid * 1024u;
    const int aoff = lds_byte(wr * 64 + fr, fq * 8), boff = lds_byte(wc * 32 + fr, fq * 8);
#define PG8_SA(b, h) (((b) * 2 + (h)) * HTB)
#define PG8_SB(b, h) ((4 + (b) * 2 + (h)) * HTB)
#define PG8_STAGE(bufoff, gbase, voff) do { _Pragma("unroll") for (int _i = 0; _i < 2; ++_i) \
        __builtin_amdgcn_global_load_lds((const unsigned*)((const char*)(gbase) + (voff)[_i]), (LAS unsigned*)(lds + (bufoff) + ldsw + _i * 8192), 16, 0, 0); } while (0)
#define PG8_LDA(dst, b, h) do { _Pragma("unroll") for (int m = 0; m < 4; ++m) _Pragma("unroll") for (int k = 0; k < 2; ++k) dst[m][k] = *(const LAS bf16x8*)(lds + PG8_SA(b, h) + aoff + m * 2048 + k * 1024); } while (0)
#define PG8_LDB(dst, b, h) do { _Pragma("unroll") for (int n = 0; n < 2; ++n) _Pragma("unroll") for (int k = 0; k < 2; ++k) dst[n][k] = *(const LAS bf16x8*)(lds + PG8_SB(b, h) + boff + n * 2048 + k * 1024); } while (0)
#define PG8_MMA(ai, bj, At, Bt) do { __builtin_amdgcn_s_setprio(1); _Pragma("unroll") for (int m = 0; m < 4; ++m) _Pragma("unroll") for (int n = 0; n < 2; ++n) _Pragma("unroll") for (int k = 0; k < 2; ++k) \
        acc[ai][bj][m][n] = __builtin_amdgcn_mfma_f32_16x16x32_bf16(Bt[n][k], At[m][k], acc[ai][bj][m][n], 0, 0, 0); __builtin_amdgcn_s_setprio(0); } while (0)
#define PG8_WAIT_V(n) asm volatile("s_waitcnt vmcnt(" #n ")" ::: "memory")
#define PG8_WAIT_L(n) asm volatile("s_waitcnt lgkmcnt(" #n ")" ::: "memory")
#define PG8_BAR __builtin_amdgcn_s_barrier()
#define PG8_SCHED __builtin_amdgcn_sched_barrier(0)
    Unit cur, nxt; int ui = 0;
    if (!S.next(0, cur)) return;
    f32x4 acc[2][2][4][2];
#pragma unroll
    for (int a = 0; a < 2; ++a)
#pragma unroll
        for (int b = 0; b < 2; ++b)
#pragma unroll
            for (int m = 0; m < 4; ++m)
#pragma unroll
                for (int n = 0; n < 2; ++n) acc[a][b][m][n] = (f32x4){0.f, 0.f, 0.f, 0.f};
    bf16x8 At[4][2], B0[2][2], B1[2][2];
    const char* cA = cur.a; const char* cB = cur.b;
    if constexpr (SP2) {
    PG8_STAGE(PG8_SB(0, 0), cB, voffB); PG8_STAGE(PG8_SB(0, 1), cB + hstepB, voffB); PG8_STAGE(PG8_SA(0, 0), cA, voffA); PG8_STAGE(PG8_SA(0, 1), cA + hstepA, voffA);
    if (wr == 1) PG8_BAR;
    PG8_WAIT_V(2); PG8_BAR;
    } else {
    PG8_STAGE(PG8_SB(0, 0), cB, voffB); PG8_STAGE(PG8_SA(0, 0), cA, voffA); PG8_STAGE(PG8_SB(0, 1), cB + hstepB, voffB); PG8_STAGE(PG8_SA(0, 1), cA + hstepA, voffA);
    if (wr == 1) PG8_BAR;
    PG8_WAIT_V(4); PG8_BAR;
    }
    PG8_STAGE(PG8_SB(1, 0), cB + kstep, voffB); PG8_STAGE(PG8_SA(1, 0), cA + kstep, voffA); PG8_STAGE(PG8_SB(1, 1), cB + hstepB + kstep, voffB);
    PG8_WAIT_V(6); PG8_BAR;
    for (;;) {
        const bool has_next = S.next(ui + 1, nxt);
        const char* nA = has_next ? nxt.a : cA; const char* nB = has_next ? nxt.b : cB;
        for (int t = 0; t < nt; t += 2) {
            const bool last = (t == nt - 2);
            const char* a1 = cA + (size_t)(t + 1) * kstep;
            const char* a2 = last ? nA : cA + (size_t)(t + 2) * kstep; const char* b2 = last ? nB : cB + (size_t)(t + 2) * kstep;
            const char* a3 = a2 + kstep; const char* b3 = b2 + kstep;
            if constexpr (SP2) {
            PG8_LDB(B0, 0, 0); PG8_LDB(B1, 0, 1); PG8_SCHED; PG8_LDA(At, 0, 0); PG8_STAGE(PG8_SA(1, 1), a1 + hstepA, voffA);
            PG8_WAIT_V(8); PG8_WAIT_L(0); PG8_BAR; PG8_MMA(0, 0, At, B0); PG8_MMA(0, 1, At, B1); PG8_BAR; PG8_SCHED;
            PG8_LDA(At, 0, 1); PG8_STAGE(PG8_SB(0, 0), b2, voffB); PG8_STAGE(PG8_SB(0, 1), b2 + hstepB, voffB); PG8_STAGE(PG8_SA(0, 0), a2, voffA);
            PG8_WAIT_V(8); PG8_WAIT_L(0); PG8_BAR; PG8_MMA(1, 0, At, B0); PG8_MMA(1, 1, At, B1); PG8_BAR; PG8_SCHED;
            PG8_LDB(B0, 1, 0); PG8_LDB(B1, 1, 1); PG8_SCHED; PG8_LDA(At, 1, 0); PG8_STAGE(PG8_SA(0, 1), a2 + hstepA, voffA);
            PG8_WAIT_V(8); PG8_WAIT_L(0); PG8_BAR; PG8_MMA(0, 0, At, B0); PG8_MMA(0, 1, At, B1); PG8_BAR; PG8_SCHED;
            PG8_LDA(At, 1, 1); PG8_STAGE(PG8_SB(1, 0), b3, voffB); PG8_STAGE(PG8_SB(1, 1), b3 + hstepB, voffB); PG8_STAGE(PG8_SA(1, 0), a3, voffA);
            PG8_WAIT_V(8); PG8_WAIT_L(0); PG8_BAR; PG8_MMA(1, 0, At, B0); PG8_MMA(1, 1, At, B1); PG8_BAR; PG8_SCHED;
            } else {
            PG8_LDB(B0, 0, 0); PG8_SCHED; PG8_LDA(At, 0, 0); PG8_STAGE(PG8_SA(1, 1), a1 + hstepA, voffA);
            PG8_WAIT_L(8); PG8_BAR; PG8_WAIT_L(0); PG8_MMA(0, 0, At, B0); PG8_BAR; PG8_SCHED;
            PG8_LDB(B1, 0, 1); PG8_STAGE(PG8_SB(0, 0), b2, voffB);
            PG8_BAR; PG8_WAIT_L(0); PG8_MMA(0, 1, At, B1); PG8_BAR;
            PG8_LDA(At, 0, 1); PG8_STAGE(PG8_SA(0, 0), a2, voffA);
            PG8_BAR; PG8_WAIT_L(0); PG8_MMA(1, 0, At, B0); PG8_BAR; PG8_SCHED;
            PG8_STAGE(PG8_SB(0, 1), b2 + hstepB, voffB);
            PG8_WAIT_V(6); PG8_BAR; PG8_MMA(1, 1, At, B1); PG8_BAR;
            PG8_LDB(B0, 1, 0); PG8_SCHED; PG8_LDA(At, 1, 0); PG8_STAGE(PG8_SA(0, 1), a2 + hstepA, voffA);
            PG8_WAIT_L(8); PG8_BAR; PG8_WAIT_L(0); PG8_MMA(0, 0, At, B0); PG8_BAR; PG8_SCHED;
            PG8_LDB(B1, 1, 1); PG8_STAGE(PG8_SB(1, 0), b3, voffB);
            PG8_BAR; PG8_WAIT_L(0); PG8_MMA(0, 1, At, B1); PG8_BAR;
            PG8_LDA(At, 1, 1); PG8_STAGE(PG8_SA(1, 0), a3, voffA);
            PG8_BAR; PG8_WAIT_L(0); PG8_MMA(1, 0, At, B0); PG8_BAR; PG8_SCHED;
            PG8_STAGE(PG8_SB(1, 1), b3 + hstepB, voffB);
            PG8_WAIT_V(6); PG8_BAR; PG8_MMA(1, 1, At, B1); PG8_BAR;
            }
        }
        if constexpr (ALIGN_EPI) { if (wr == 0) PG8_BAR; }
        bool zero_acc = true;
        if constexpr (Epi::CHAIN) zero_acc = E.chain(acc, cur, wr, wc, fr, fq); else E(acc, cur, wr, wc, fr, fq);
        if (!has_next) break;
        if (zero_acc)
#pragma unroll
        for (int a = 0; a < 2; ++a)
#pragma unroll
            for (int b = 0; b < 2; ++b)
#pragma unroll
                for (int m = 0; m < 4; ++m)
#pragma unroll
                    for (int n = 0; n < 2; ++n) acc[a][b][m][n] = (f32x4){0.f, 0.f, 0.f, 0.f};
        cur = nxt; cA = nA; cB = nB; ++ui;
        if constexpr (ALIGN_EPI) { if (wr == 1) PG8_BAR; }
    }
    PG8_WAIT_V(0);
    if constexpr (!ALIGN_EPI) { if (wr == 0) PG8_BAR; }
    PG8_BAR;
#undef PG8_SA
#undef PG8_SB
#undef PG8_STAGE
#undef PG8_LDA
#undef PG8_LDB
#undef PG8_MMA
#undef PG8_WAIT_V
#undef PG8_WAIT_L
#undef PG8_BAR
#undef PG8_SCHED
}

__device__ __forceinline__ u32x4 pack8(const f32x4& v0, const f32x4& v1) {
    u32x4 o; o[0] = cvtpk(v0[0], v0[1]); o[1] = cvtpk(v0[2], v0[3]); o[2] = cvtpk(v1[0], v1[1]); o[3] = cvtpk(v1[2], v1[3]); return o;
}

struct SchedNat {
    static constexpr int BHALF_ROWS = 128; static __device__ __forceinline__ int bmap(int R) { return R; }
    const char* H; const char* W; int G, c;
    __device__ bool next(int i, Unit& u) const {
        if (!tile_order((long)i * G + c, NTOK / 256, NNAT / 256, u.pm, u.pn)) return false;
        u.a = H + (size_t)u.pm * 256 * 2048; u.b = W + (size_t)u.pn * 256 * 2048; u.aux = 0; return true;
    }
};
struct EpiNat {
    static constexpr bool PERM = true, CHAIN = false;
    unsigned char* ws;
    __device__ __forceinline__ void operator()(const f32x4 (&acc)[2][2][4][2], const Unit& u, int wr, int wc, int fr, int fq) const {
        const int colt = u.pn * 256;
        size_t base; int ld, c0; float scale = 1.f;
        if (colt < 512) { base = WS_AQ; ld = 512; c0 = colt; }
        else if (colt < 1024) { base = WS_AK; ld = 512; c0 = colt - 512; scale = 0.08838834764831845f; }
        else if (colt < 8192) { const int s = (colt - 1024) >> 10; ld = 1024; c0 = (colt - 1024) & 1023;
            base = s == 0 ? WS_AO : s == 1 ? WS_AZ : s == 2 ? WS_BQ : s == 3 ? WS_BK : s == 4 ? WS_BZ : s == 5 ? WS_CU : WS_CZ; }
        else { base = WS_MG; ld = 3072; c0 = colt - 8192; }
        bf16_t* O = (bf16_t*)(ws + base);
        const int row0 = u.pm * 256 + wr * 64 + fr, col0 = c0 + wc * 32 + 8 * fq;
#pragma unroll
        for (int ai = 0; ai < 2; ++ai)
#pragma unroll
            for (int m = 0; m < 4; ++m) { bf16_t* rowp = O + (size_t)(row0 + ai * 128 + m * 16) * ld + col0;
#pragma unroll
                for (int bj = 0; bj < 2; ++bj) *(u32x4*)(rowp + bj * 128) = pack8(acc[ai][bj][m][0] * scale, acc[ai][bj][m][1] * scale); }
    }
};
struct SchedTr {
    static constexpr int BHALF_ROWS = 128; static __device__ __forceinline__ int bmap(int R) { return R; }
    const char* H; const char* W; int G, c;
    __device__ bool next(int i, Unit& u) const {
        if (!tile_order((long)i * G + c, NTR / 256, NTOK / 256, u.pm, u.pn)) return false;
        u.a = W + (size_t)u.pm * 256 * 2048; u.b = H + (size_t)u.pn * 256 * 2048; u.aux = 0; return true;
    }
};
struct EpiTr {
    static constexpr bool PERM = true, CHAIN = false;
    unsigned char* ws;
    __device__ __forceinline__ void operator()(const f32x4 (&acc)[2][2][4][2], const Unit& u, int wr, int wc, int fr, int fq) const {
        const int rt = u.pm * 256;
        size_t base; int nrows, r0; float scale = 1.f;
        if (rt < 512) { base = WS_AKT; nrows = 512; r0 = rt; scale = 0.08838834764831845f; }
        else if (rt < 1536) { base = WS_AVT; nrows = 1024; r0 = rt - 512; }
        else { base = WS_BVT; nrows = 1024; r0 = rt - 1536; }
        const int tt0 = u.pn * 256, b = tt0 / TB, tb0 = tt0 - b * TB;
        bf16_t* O = (bf16_t*)(ws + base) + ((size_t)b * nrows + r0) * TB + tb0;
        const int row0 = wr * 64 + fr, col0 = wc * 32 + 8 * fq;
#pragma unroll
        for (int ai = 0; ai < 2; ++ai)
#pragma unroll
            for (int m = 0; m < 4; ++m) { bf16_t* rowp = O + (size_t)(row0 + ai * 128 + m * 16) * TB + col0;
#pragma unroll
                for (int bj = 0; bj < 2; ++bj) *(u32x4*)(rowp + bj * 128) = pack8(acc[ai][bj][m][0] * scale, acc[ai][bj][m][1] * scale); }
    }
};
struct SchedF1L {
    static constexpr int BHALF_ROWS = 16; static __device__ __forceinline__ int bmap(int R) { return 64 * (R & 7) + (R >> 3); }
    const char* T2A; const char* CU; int G, c;
    __device__ bool next(int i, Unit& u) const {
        const long L = (long)i * G + c; if (L >= 4 * 2 * 64) return false;
        const int g = (int)(L >> 7), rem = (int)(L & 127); u.pm = rem >> 6; const int bt = rem & 63, b = bt >> 4, tl = bt & 15; u.pn = bt; u.aux = g;
        u.a = T2A + (size_t)u.pm * 256 * 512; u.b = CU + ((size_t)b * TB + 256 + 512 * (tl >> 1) + 32 * (tl & 1)) * 2048 + (size_t)g * 512; return true;
    }
};
struct EpiF1L {
    static constexpr bool PERM = true, CHAIN = false;
    unsigned char* ws;
    __device__ __forceinline__ void operator()(const f32x4 (&acc)[2][2][4][2], const Unit& u, int wr, int wc, int fr, int fq) const {
        const int part = u.pm, g = u.aux, b = u.pn >> 4, tl = u.pn & 15, a8 = 8 * (tl >> 1), n20 = 32 * (tl & 1);
        bf16_t* Z = (bf16_t*)(ws + WS_ZTL);
        const int row0 = wr * 64 + fr;
#pragma unroll
        for (int ai = 0; ai < 2; ++ai)
#pragma unroll
            for (int m = 0; m < 4; ++m) { const int ch = g * 256 + row0 + ai * 128 + m * 16;
#pragma unroll
                for (int bj = 0; bj < 2; ++bj) { const int n2 = n20 + 16 * bj + 4 * wc + fq;
                    *(u32x4*)(Z + ((size_t)(b * 1024 + ch) * 64 + n2) * 128 + part * 64 + a8) = pack8(acc[ai][bj][m][0], acc[ai][bj][m][1]); } }
    }
};
struct SchedF1C {
    static constexpr int BHALF_ROWS = 128; static __device__ __forceinline__ int bmap(int R) { return R; }
    const char* T2A; const char* CU; int G, c;
    __device__ bool next(int i, Unit& u) const {
        const long L = (long)i * G + c; if (L >= 4 * 2 * 4) return false;
        const int g = (int)(L >> 3), rem = (int)(L & 7); u.pm = rem >> 2; u.pn = rem & 3; u.aux = g;
        u.a = T2A + (size_t)u.pm * 256 * 512; u.b = CU + ((size_t)u.pn * TB) * 2048 + (size_t)g * 512; return true;
    }
};
struct EpiF1C {
    static constexpr bool PERM = true, CHAIN = false;
    unsigned char* ws;
    __device__ __forceinline__ void operator()(const f32x4 (&acc)[2][2][4][2], const Unit& u, int wr, int wc, int fr, int fq) const {
        const int part = u.pm, g = u.aux, b = u.pn;
        bf16_t* Z = (bf16_t*)(ws + WS_ZTC);
        const int row0 = wr * 64 + fr, col0 = wc * 32 + 8 * fq;
#pragma unroll
        for (int ai = 0; ai < 2; ++ai)
#pragma unroll
            for (int m = 0; m < 4; ++m) { const int ch = g * 256 + row0 + ai * 128 + m * 16;
                bf16_t* rowp = Z + ((size_t)(b * 1024 + ch) * 2 + part) * 256 + col0;
#pragma unroll
                for (int bj = 0; bj < 2; ++bj) *(u32x4*)(rowp + bj * 128) = pack8(acc[ai][bj][m][0], acc[ai][bj][m][1]); }
    }
};
struct SchedFA {
    static constexpr int BHALF_ROWS = 128; static __device__ __forceinline__ int bmap(int R) { return R; }
    const char* Zp; const char* F2T; int G, c;
    __device__ bool next(int i, Unit& u) const {
        const long L = (long)i * G + c; if (L >= 1024) return false;
        u.pm = (int)L; u.pn = 0; u.aux = 0; u.a = Zp + (size_t)L * 256 * 256; u.b = F2T; return true;
    }
};
struct EpiFA {
    static constexpr bool PERM = true, CHAIN = false;
    unsigned char* ws;
    __device__ __forceinline__ void operator()(const f32x4 (&acc)[2][2][4][2], const Unit& u, int wr, int wc, int fr, int fq) const {
        unsigned* Ap = (unsigned*)(ws + WS_T1);
        const int k10 = 16 * wc + 4 * fq;
#pragma unroll
        for (int ai = 0; ai < 2; ++ai)
#pragma unroll
            for (int m = 0; m < 4; ++m) { const int r = u.pm * 256 + ai * 128 + wr * 64 + m * 16 + fr, n2 = r & 63, ch = (r >> 6) & 1023, b = r >> 16;
#pragma unroll
                for (int q = 0; q < 4; ++q) { const int k1 = k10 + q; const f32x4 v = acc[ai][0][m][q >> 1];
                    const float ar = v[2 * (q & 1)], aim = v[2 * (q & 1) + 1];
                    const float rev = (float)(n2 * k1) * (1.f / 4096.f), cs = __builtin_amdgcn_cosf(rev), sn = __builtin_amdgcn_sinf(rev);
                    __hip_atomic_store(&Ap[((size_t)(b * 64 + k1) * 1024 + ch) * 64 + n2], cvtpk(ar * cs + aim * sn, aim * cs - ar * sn), __ATOMIC_RELAXED, __HIP_MEMORY_SCOPE_AGENT); } }
    }
};
struct SchedFB {
    static constexpr int BHALF_ROWS = 128; static __device__ __forceinline__ int bmap(int R) { return R; }
    const char* G2T; const char* Ap; int base;
    __device__ bool next(int i, Unit& u) const {
        if (i >= 4) return false; const long L = base + i;
        u.pm = 0; u.pn = (int)L; u.aux = 0; u.a = G2T; u.b = Ap + (size_t)L * 256 * 256; return true;
    }
};
struct EpiFB {
    static constexpr bool PERM = true, CHAIN = false;
    unsigned char* ws;
    __device__ __forceinline__ void operator()(const f32x4 (&acc)[2][2][4][2], const Unit& u, int wr, int wc, int fr, int fq) const {
        if (wr != 0) return;
        bf16_t* CZ = (bf16_t*)(ws + WS_CZ);
        const int R0 = u.pn * 256, b = R0 >> 16, k1 = (R0 >> 10) & 63, ch0 = (R0 & 1023) + wc * 32 + 8 * fq;
#pragma unroll
        for (int m = 0; m < 4; ++m) { const int k2 = 16 * m + fr;
            bf16_t* rowp = CZ + ((size_t)b * TB + 256 + k1 + 64 * k2) * 1024 + ch0;
#pragma unroll
            for (int bj = 0; bj < 2; ++bj) {
                const u32x4 z = *(const u32x4*)(rowp + bj * 128);
                f32x4 v0 = acc[0][bj][m][0] * (1.f / 1024.f), v1 = acc[0][bj][m][1] * (1.f / 1024.f);
                v0[0] *= silu(bf_lo(z[0])); v0[1] *= silu(bf_hi(z[0])); v0[2] *= silu(bf_lo(z[1])); v0[3] *= silu(bf_hi(z[1]));
                v1[0] *= silu(bf_lo(z[2])); v1[1] *= silu(bf_hi(z[2])); v1[2] *= silu(bf_lo(z[3])); v1[3] *= silu(bf_hi(z[3]));
                *(u32x4*)(rowp + bj * 128) = pack8(v0, v1); } }
    }
};
struct SchedOne {
    static constexpr int BHALF_ROWS = 128; static __device__ __forceinline__ int bmap(int R) { return R; }
    Unit u0;
    __device__ bool next(int i, Unit& u) const { if (i != 0) return false; u = u0; return true; }
};
struct EpiF2 {
    static constexpr bool PERM = true, CHAIN = false;
    unsigned char* ws; float scale;
    __device__ __forceinline__ void operator()(const f32x4 (&acc)[2][2][4][2], const Unit& u, int wr, int wc, int fr, int fq) const {
        bf16_t* CZ = (bf16_t*)(ws + WS_CZ);
        const int row0 = u.aux + wr * 64 + fr, col0 = u.pn * 256 + wc * 32 + 8 * fq;
#pragma unroll
        for (int ai = 0; ai < 2; ++ai)
#pragma unroll
            for (int m = 0; m < 4; ++m) { bf16_t* rowp = CZ + (size_t)(row0 + ai * 128 + m * 16) * 1024 + col0;
#pragma unroll
                for (int bj = 0; bj < 2; ++bj) {
                    const u32x4 z = *(const u32x4*)(rowp + bj * 128);
                    f32x4 v0 = acc[ai][bj][m][0] * scale, v1 = acc[ai][bj][m][1] * scale;
                    v0[0] *= silu(bf_lo(z[0])); v0[1] *= silu(bf_hi(z[0])); v0[2] *= silu(bf_lo(z[1])); v0[3] *= silu(bf_hi(z[1]));
                    v1[0] *= silu(bf_lo(z[2])); v1[1] *= silu(bf_hi(z[2])); v1[2] *= silu(bf_lo(z[3])); v1[3] *= silu(bf_hi(z[3]));
                    *(u32x4*)(rowp + bj * 128) = pack8(v0, v1); } }
    }
};
struct SchedM {
    static constexpr int BHALF_ROWS = 128; static __device__ __forceinline__ int bmap(int R) { return R; }
    const char* A; const char* W; int G, c; int skipctx;
    __device__ bool next(int i, Unit& u) const {
        if (!tile_order((long)i * G + c, skipctx ? 64 : 68, 4, u.pm, u.pn)) return false;
        if (skipctx) u.pm = (u.pm >> 4) * 17 + 1 + (u.pm & 15);
        u.a = A + (size_t)u.pm * 256 * 2048; u.b = W + (size_t)u.pn * 256 * 2048; u.aux = 0; return true;
    }
};
struct SchedM1C {
    static constexpr int BHALF_ROWS = 128; static __device__ __forceinline__ int bmap(int R) { return R; }
    const char* ws; int G, c; int skipctx;
    __device__ bool next(int i, Unit& u) const {
        const int un = i / 3, br = i - 3 * un;
        if (!tile_order((long)un * G + c, skipctx ? 64 : 68, 4, u.pm, u.pn)) return false;
        if (skipctx) u.pm = (u.pm >> 4) * 17 + 1 + (u.pm & 15);
        const size_t ybase = br == 0 ? WS_AO : (br == 1 ? WS_BZ : WS_CZ);
        u.a = ws + ybase + (size_t)u.pm * 256 * 2048; u.b = ws + WS_WOUT + (size_t)br * 2097152 + (size_t)u.pn * 256 * 2048; u.aux = br; return true;
    }
};
struct SchedM1Cq {
    static constexpr int BHALF_ROWS = 128; static __device__ __forceinline__ int bmap(int R) { return R; }
    const char* ws; int pm, pn;
    __device__ bool next(int i, Unit& u) const {
        if (i >= 3) return false; const int br = i; u.pm = pm; u.pn = pn;
        const size_t ybase = br == 0 ? WS_AO : (br == 1 ? WS_BZ : WS_CZ);
        u.a = ws + ybase + (size_t)pm * 256 * 2048; u.b = ws + WS_WOUT + (size_t)br * 2097152 + (size_t)pn * 256 * 2048; u.aux = br; return true;
    }
};
struct EpiM1C {
    static constexpr bool PERM = true, CHAIN = true;
    unsigned char* ws;
    __device__ __forceinline__ float epl(float g) const { return 1.f + __expf(-fminf(fmaxf(g, -30.f), 30.f)); }
    __device__ __forceinline__ bool chain(f32x4 (&acc)[2][2][4][2], const Unit& u, int wr, int wc, int fr, int fq) const {
        const bf16_t* MG = (const bf16_t*)(ws + WS_MG);
        bf16_t* YM = (bf16_t*)(ws + WS_H);
        const int br = u.aux;
        const int row0 = u.pm * 256 + wr * 64 + fr, col0 = u.pn * 256 + wc * 32 + 8 * fq;
        const int brn = br < 2 ? br + 1 : br;
#pragma unroll
        for (int ai = 0; ai < 2; ++ai) {
            u32x4 gc[4][2], gn[4][2];
#pragma unroll
            for (int m = 0; m < 4; ++m) { const size_t row = (size_t)(row0 + ai * 128 + m * 16);
#pragma unroll
                for (int bj = 0; bj < 2; ++bj) { const int col = col0 + bj * 128;
                    gc[m][bj] = *(const u32x4*)(MG + row * 3072 + br * 1024 + col); gn[m][bj] = *(const u32x4*)(MG + row * 3072 + brn * 1024 + col); } }
#pragma unroll
            for (int m = 0; m < 4; ++m) { const size_t row = (size_t)(row0 + ai * 128 + m * 16);
#pragma unroll
                for (int bj = 0; bj < 2; ++bj) { const int col = col0 + bj * 128;
                    const u32x4 g = gc[m][bj], gnn = gn[m][bj];
                    float f[8];
                    if (br < 2) {
#pragma unroll
                        for (int q = 0; q < 4; ++q) { f[2 * q] = epl(bf_lo(gnn[q])) * __builtin_amdgcn_rcpf(epl(bf_lo(g[q]))); f[2 * q + 1] = epl(bf_hi(gnn[q])) * __builtin_amdgcn_rcpf(epl(bf_hi(g[q]))); } }
                    else {
#pragma unroll
                        for (int q = 0; q < 4; ++q) { f[2 * q] = __builtin_amdgcn_rcpf(epl(bf_lo(g[q]))); f[2 * q + 1] = __builtin_amdgcn_rcpf(epl(bf_hi(g[q]))); } }
                    f32x4 v0 = acc[ai][bj][m][0], v1 = acc[ai][bj][m][1];
                    v0[0] *= f[0]; v0[1] *= f[1]; v0[2] *= f[2]; v0[3] *= f[3]; v1[0] *= f[4]; v1[1] *= f[5]; v1[2] *= f[6]; v1[3] *= f[7];
                    if (br < 2) { acc[ai][bj][m][0] = v0; acc[ai][bj][m][1] = v1; }
                    else *(u32x4*)(YM + row * 1024 + col) = pack8(v0, v1); } }
        }
        return br == 2;
    }
};
struct EpiM2 {
    static constexpr bool PERM = false, CHAIN = false;
    const float* xsrc; const float* csrc; float* xdst; float* cdst; const float* mod;
    __device__ __forceinline__ void operator()(const f32x4 (&acc)[2][2][4][2], const Unit& u, int wr, int wc, int fr, int fq) const {
        const int tt0 = u.pm * 256, b = tt0 / TB, tb0 = tt0 - b * TB;
        const bool isctx = tb0 < 256;
        const float* src = isctx ? csrc + (size_t)b * 256 * 1024 : xsrc + ((size_t)b * 4096 + (tb0 - 256)) * 1024;
        float* dst = isctx ? cdst + (size_t)b * 256 * 1024 : xdst + ((size_t)b * 4096 + (tb0 - 256)) * 1024;
        const float* gate = mod + (isctx ? 4 : b) * 3072 + 2048;
        const int row0 = wr * 64 + fr, col0 = u.pn * 256 + wc * 32 + 4 * fq;
        f32x4 gv[2][2];
#pragma unroll
        for (int bj = 0; bj < 2; ++bj)
#pragma unroll
            for (int n = 0; n < 2; ++n) gv[bj][n] = *(const f32x4*)(gate + col0 + bj * 128 + n * 16);
#pragma unroll
        for (int ai = 0; ai < 2; ++ai)
#pragma unroll
            for (int m = 0; m < 4; ++m) { const size_t ro = (size_t)(row0 + ai * 128 + m * 16) * 1024 + col0;
#pragma unroll
                for (int bj = 0; bj < 2; ++bj)
#pragma unroll
                    for (int n = 0; n < 2; ++n) { const size_t o = ro + bj * 128 + n * 16;
                        *(f32x4*)(dst + o) = *(const f32x4*)(src + o) + gv[bj][n] * acc[ai][bj][m][n]; } }
    }
};

__device__ __forceinline__ void convert_item(const Params& p, LAS unsigned char* lds, int l, int item) {
    const int tid = tid_opaque();
    const int kt = item & 15, nt = item >> 4;
    const float* src; size_t src_ld; int c0; bf16_t* dst;
    if (nt < 176) { const int n = nt * 64; c0 = n < 1024 ? n : (n < 5120 ? n + 1040 : n + 2064);
        src = p.in[7] + (size_t)l * DM * DIN; src_ld = DIN; dst = (bf16_t*)(p.ws + WS_WNAT) + (size_t)n * 1024; }
    else if (nt < 216) { const int n = (nt - 176) * 64; c0 = n < 512 ? n + 512 : (n < 1536 ? n + 512 : n + 4624);
        src = p.in[7] + (size_t)l * DM * DIN; src_ld = DIN; dst = (bf16_t*)(p.ws + WS_WTR) + (size_t)n * 1024; }
    else { const int j = (nt - 216) >> 4, n = ((nt - 216) & 15) * 64; c0 = n;
        const float* w0 = p.in[17]; const float* w1 = p.in[18]; const float* w2 = p.in[19]; const float* w3 = p.in[20];
        asm volatile("" : "+s"(w0), "+s"(w1), "+s"(w2), "+s"(w3));
        src = (j == 0 ? w0 : j == 1 ? w1 : j == 2 ? w2 : w3) + (size_t)l * DM * DM; src_ld = DM; dst = (bf16_t*)(p.ws + WS_WOUT) + (size_t)j * DM * DM + (size_t)n * 1024; }
    LAS float* T = (LAS float*)(lds + 65536);
    const int k0 = kt * 64;
#pragma unroll
    for (int i = 0; i < 2; ++i) { const int idx = tid + 512 * i, kk = idx >> 4, c4 = (idx & 15) * 4;
        const f32x4 v = *(const f32x4*)(src + (size_t)(k0 + kk) * src_ld + c0 + c4);
        T[kk * 65 + c4] = v[0]; T[kk * 65 + c4 + 1] = v[1]; T[kk * 65 + c4 + 2] = v[2]; T[kk * 65 + c4 + 3] = v[3]; }
    __syncthreads();
    { const int n = tid >> 3, ks = (tid & 7) * 8;
      u32x4 o;
#pragma unroll
      for (int j = 0; j < 4; ++j) o[j] = cvtpk(T[(ks + 2 * j) * 65 + n], T[(ks + 2 * j + 1) * 65 + n]);
      *(u32x4*)(dst + (size_t)n * 1024 + k0 + ks) = o; }
    __syncthreads();
}
constexpr int N_CONV_ITEMS = 280 * 16;

__device__ __forceinline__ void phase0(const Params& p, LAS unsigned char* lds) {
    const int tid = tid_opaque(), G = gridDim.x, bid = blockIdx.x;
    LAS float* ctab = (LAS float*)lds;
    LAS float* sc = (LAS float*)(lds + 16384);
    LAS float* red = (LAS float*)(lds + 40960);
    for (int i = tid; i < 4096; i += 512) ctab[i] = cospif((float)i * (1.f / 2048.f));
    for (int i = tid; i < 5 * 1024; i += 512) { const float v = i < 4096 ? p.in[1][i] : p.in[3][i - 4096]; sc[i] = v / (1.f + expf(-v)); }
    __syncthreads();
    const int n_mod = 192, n_t1 = 2, n_t2 = 32;
    const int total = n_mod + n_t1 + n_t2 + N_CONV_ITEMS;
    for (int item = bid; item < total; item += G) {
        if (item < n_mod) {
            const int l = item / 48, j0 = (item % 48) * 64, col = tid & 63, kp = tid >> 6;
            const float* w = p.in[5] + ((size_t)l * 1024 + kp * 128) * 3072 + j0 + col;
            float a0 = 0.f, a1 = 0.f, a2 = 0.f, a3 = 0.f, a4 = 0.f;
#pragma unroll 8
            for (int k = 0; k < 128; ++k) { const float wv = w[(size_t)k * 3072]; const int kk = kp * 128 + k;
                a0 += sc[kk] * wv; a1 += sc[1024 + kk] * wv; a2 += sc[2048 + kk] * wv; a3 += sc[3072 + kk] * wv; a4 += sc[4096 + kk] * wv; }
            red[(kp * 5 + 0) * 64 + col] = a0; red[(kp * 5 + 1) * 64 + col] = a1; red[(kp * 5 + 2) * 64 + col] = a2; red[(kp * 5 + 3) * 64 + col] = a3; red[(kp * 5 + 4) * 64 + col] = a4;
            __syncthreads();
            if (tid < 320) { const int v = tid >> 6, c = tid & 63; float s = p.in[6][(size_t)l * 3072 + j0 + c];
#pragma unroll
                for (int q = 0; q < 8; ++q) s += red[(q * 5 + v) * 64 + c];
                ((float*)(p.ws + WS_MOD))[(size_t)(l * 5 + v) * 3072 + j0 + c] = s; }
            __syncthreads();
        } else if (item < n_mod + n_t1) {
            const int which = item - n_mod;
            bf16_t* T = (bf16_t*)(p.ws + (which == 0 ? WS_F2T : WS_G2T));
            for (int e = tid; e < 256 * 16; e += 512) { const int r = e >> 4, j0 = (e & 15) * 8; u32x4 o;
#pragma unroll
                for (int q = 0; q < 4; ++q) { float v[2];
#pragma unroll
                    for (int z = 0; z < 2; ++z) { const int j = j0 + 2 * q + z; float val = 0.f;
                        if (which == 0) { if (r < 128) { const int k1 = r >> 1, c = r & 1, part = j >> 6, n1 = j & 63, m = ((k1 * n1) & 63) * 64;
                                const int sh = (c == 0) ? (part == 0 ? 0 : 1024) : (part == 0 ? 1024 : 2048); val = ctab[(m + sh) & 4095]; } }
                        else { if (r < 64) { const int n2 = j >> 1, c = j & 1, m = ((r * n2) & 63) * 64; val = ctab[(m + (c == 0 ? 0 : 3072)) & 4095]; } }
                        v[z] = val; }
                    o[q] = cvtpk(v[0], v[1]); }
                *(u32x4*)(T + (size_t)r * 128 + j0) = o; }
        } else if (item < n_mod + n_t1 + n_t2) {
            const int it = item - n_mod - n_t1;
            if (it < 16) {
                bf16_t* T = (bf16_t*)(p.ws + WS_T2A);
                for (int e = tid; e < 32 * 32; e += 512) { const int r = it * 32 + (e >> 5), n0 = (e & 31) * 8; u32x4 o;
#pragma unroll
                    for (int q = 0; q < 4; ++q) { float v[2];
#pragma unroll
                        for (int z = 0; z < 2; ++z) { const int n = n0 + 2 * q + z; const int m = r < 256 ? ((r * n) & 255) * 16 : ((((r - 256) * n) & 255) * 16 - 1024) & 4095; v[z] = ctab[m]; }
                        o[q] = cvtpk(v[0], v[1]); }
                    *(u32x4*)(T + (size_t)r * 256 + n0) = o; }
            } else {
                bf16_t* T = (bf16_t*)(p.ws + WS_T2B);
                for (int e = tid; e < 16 * 64; e += 512) { const int r = (it - 16) * 16 + (e >> 6), j0 = (e & 63) * 8; u32x4 o;
#pragma unroll
                    for (int q = 0; q < 4; ++q) { float v[2];
#pragma unroll
                        for (int z = 0; z < 2; ++z) { const int j = j0 + 2 * q + z; const int m = j < 256 ? ((r * j) & 255) * 16 : ((((r * (j - 256)) & 255) * 16) + 1024) & 4095; v[z] = ctab[m]; }
                        o[q] = cvtpk(v[0], v[1]); }
                    *(u32x4*)(T + (size_t)r * 512 + j0) = o; }
            }
        } else {
            convert_item(p, lds, 0, item - n_mod - n_t1 - n_t2);
        }
    }
}

__device__ __forceinline__ void phase_prenorm(const Params& p, LAS unsigned char* lds, int l) {
    const int tid = tid_opaque(), lane = tid & 63, w = tid >> 6, G = gridDim.x, bid = blockIdx.x;
    LAS float* gw = (LAS float*)lds;
    { const float* wi = p.in[7] + (size_t)l * DM * DIN + 2048;
      for (int k = tid; k < 1024; k += 512) {
#pragma unroll
          for (int q = 0; q < 4; ++q) { const f32x4 v = *(const f32x4*)(wi + (size_t)k * DIN + 4 * q);
              gw[(4 * q + 0) * 1024 + k] = v[0]; gw[(4 * q + 1) * 1024 + k] = v[1]; gw[(4 * q + 2) * 1024 + k] = v[2]; gw[(4 * q + 3) * 1024 + k] = v[3]; } } }
    __syncthreads();
    const float* xsrc = l == 0 ? p.in[0] : p.out;
    const float* csrc = l == 0 ? p.in[2] : (const float*)(p.ws + WS_CTXS);
    const float* nw = p.in[4] + (size_t)l * 1024;
    const float* mod = (const float*)(p.ws + WS_MOD) + (size_t)l * 5 * 3072;
    bf16_t* H = (bf16_t*)(p.ws + WS_H);
    float* GT = (float*)(p.ws + WS_GATES);
    for (int r = bid * 8 + w; r < NTOK; r += G * 8) {
        const int b = r / TB, tb = r - b * TB;
        const float* xr = tb < 256 ? csrc + ((size_t)b * 256 + tb) * 1024 : xsrc + ((size_t)b * 4096 + tb - 256) * 1024;
        const float* md = mod + (tb < 256 ? 4 : b) * 3072;
        f32x4 x[4]; float ss = 0.f;
#pragma unroll
        for (int c = 0; c < 4; ++c) { x[c] = *(const f32x4*)(xr + c * 256 + lane * 4); ss += x[c][0] * x[c][0] + x[c][1] * x[c][1] + x[c][2] * x[c][2] + x[c][3] * x[c][3]; }
        ss = wave_sum(ss);
        const float rinv = rsqrtf(ss * (1.f / 1024.f) + EPS);
#pragma unroll
        for (int c = 0; c < 4; ++c) { const int k = c * 256 + lane * 4;
            const f32x4 wv = *(const f32x4*)(nw + k), sh = *(const f32x4*)(md + k), sca = *(const f32x4*)(md + 1024 + k);
#pragma unroll
            for (int e = 0; e < 4; ++e) x[c][e] = (x[c][e] * rinv) * wv[e] * (1.f + sca[e]) + sh[e];
            u32x2 o; o[0] = cvtpk(x[c][0], x[c][1]); o[1] = cvtpk(x[c][2], x[c][3]);
            *(u32x2*)(H + (size_t)r * 1024 + k) = o; }
        float mine = 0.f;
#pragma unroll
        for (int j = 0; j < 16; ++j) { float a = 0.f;
#pragma unroll
            for (int c = 0; c < 4; ++c) { const f32x4 g = *(const LAS f32x4*)(gw + j * 1024 + c * 256 + lane * 4);
                a += x[c][0] * g[0] + x[c][1] * g[1] + x[c][2] * g[2] + x[c][3] * g[3]; }
            a = wave_sum(a);
            if (lane == j) mine = a; }
        if (lane < 16) { float pre = mine + p.in[8][l * 16 + lane];
            const int ty = lane >> 2;
            if (ty & 1) pre = fminf(pre, 0.f) - __logf(1.f + __expf(-fabsf(pre)));
            GT[(size_t)r * 16 + lane] = pre; }
    }
    __syncthreads();
}

__device__ __forceinline__ void phase_qkprep(const Params& p, LAS unsigned char* lds, int l) {
    const int tid = tid_opaque(), lane = tid & 63, w = tid >> 6, G = gridDim.x, bid = blockIdx.x;
    LAS float* rc = (LAS float*)lds;
    LAS float* rs = (LAS float*)(lds + 4096);
    for (int i = tid; i < 1024; i += 512) { const int pos = i >> 4, j = i & 15;
        const float invf = powf(10000.f, -(float)(2 * j) / 32.f); float s, c; sincosf((float)pos * invf, &s, &c); rc[i] = c; rs[i] = s; }
    __syncthreads();
    const int qi = lane & 3;
    float wq[16], wk[16];
#pragma unroll
    for (int j = 0; j < 16; ++j) { wq[j] = p.in[10][l * 64 + qi * 16 + j]; wk[j] = p.in[11][l * 64 + qi * 16 + j]; }
    for (int r = bid * 8 + w; r < NTOK; r += G * 8) {
        const int b = r / TB, tb = r - b * TB;
        const bool lat = tb >= 256;
        const int pp = tb - 256, pos = (qi < 2) ? (pp >> 6) : (pp & 63);
#pragma unroll
        for (int which = 0; which < 2; ++which) {
            bf16_t* rowp = (bf16_t*)(p.ws + (which == 0 ? WS_BQ : WS_BK)) + (size_t)r * 1024 + lane * 16;
            const u32x4 u0 = *(const u32x4*)rowp, u1 = *(const u32x4*)(rowp + 8);
            float v[16];
#pragma unroll
            for (int q = 0; q < 4; ++q) { v[2 * q] = bf_lo(u0[q]); v[2 * q + 1] = bf_hi(u0[q]); v[8 + 2 * q] = bf_lo(u1[q]); v[8 + 2 * q + 1] = bf_hi(u1[q]); }
            float ss = 0.f;
#pragma unroll
            for (int j = 0; j < 16; ++j) ss += v[j] * v[j];
            ss += __shfl_xor(ss, 1); ss += __shfl_xor(ss, 2);
            const float rinv = rsqrtf(ss * (1.f / 64.f) + EPS);
#pragma unroll
            for (int j = 0; j < 16; ++j) v[j] = (v[j] * rinv) * (which == 0 ? wq[j] : wk[j]);
            if (lat) {
#pragma unroll
                for (int j = 0; j < 16; ++j) { const float other = __shfl_xor(v[j], 1); const float c = rc[pos * 16 + j], s = rs[pos * 16 + j];
                    v[j] = (qi & 1) ? (v[j] * c + other * s) : (v[j] * c - other * s); }
            }
            if (which == 0) {
#pragma unroll
                for (int j = 0; j < 16; ++j) v[j] *= 0.125f * LOG2E;
            }
            u32x4 o0, o1;
#pragma unroll
            for (int q = 0; q < 4; ++q) { o0[q] = cvtpk(v[2 * q], v[2 * q + 1]); o1[q] = cvtpk(v[8 + 2 * q], v[8 + 2 * q + 1]); }
            *(u32x4*)rowp = o0; *(u32x4*)(rowp + 8) = o1;
        }
    }
    __syncthreads();
}

__device__ __forceinline__ int swap23(int x) { return (x & ~12) | ((x & 4) << 1) | ((x & 8) >> 1); }
#define MFMA32(a, b, c) __builtin_amdgcn_mfma_f32_32x32x16_bf16((a), (b), (c), 0, 0, 0)
#define MFMA16(a, b, c) __builtin_amdgcn_mfma_f32_16x16x32_bf16((a), (b), (c), 0, 0, 0)

__device__ __forceinline__ int krow_perm(int k) { return (k & ~31) | (((k >> 2) & 1) << 4) | (((k >> 3) & 3) << 2) | (k & 3); }

template <bool SHIFT>
__device__ __forceinline__ void attn_body(const Params& p, LAS unsigned char* lds, int l, int b, int h, int q0, int nkt) {
    const int tid = tid_opaque(), w = tid >> 6, lane = tid & 63, fr = lane & 15, fg = lane >> 4, mp = w & 1, pr = w >> 1;
    constexpr int KSTR = 272, VSTR = 272, KBUF = 128 * KSTR, VBUF = 128 * VSTR;
    const float wqm = wave_max(fabsf(p.in[10][l * 64 + lane])), wkm = wave_max(fabsf(p.in[11][l * 64 + lane]));
    const float mb = 8.f * wqm * wkm * LOG2E;
    const float s1 = wave_sum(p.in[12][l * 64 + lane] * p.in[13][l * 64 + lane]), s2 = wave_sum(p.in[14][l * 64 + lane] * p.in[15][l * 64 + lane]);
    const float lam_init = 0.8f - 0.6f * expf(-0.3f * (float)l);
    const float lam = expf(s1) - expf(s2) + lam_init;
    const bf16_t* qbase = (const bf16_t*)(p.ws + WS_BQ) + ((size_t)(b * TB + q0 + 32 * pr + fr)) * 1024 + h * 128 + mp * 64;
    bf16x8 qf[2][2];
#pragma unroll
    for (int qg = 0; qg < 2; ++qg)
#pragma unroll
        for (int s = 0; s < 2; ++s) qf[qg][s] = *(const bf16x8*)(qbase + (size_t)(16 * qg) * 1024 + s * 32 + fg * 8);
    f32x4 O[2][8];
#pragma unroll
    for (int qg = 0; qg < 2; ++qg)
#pragma unroll
        for (int t = 0; t < 8; ++t) O[qg][t] = (f32x4){0.f, 0.f, 0.f, 0.f};
    float lsum[2] = {0.f, 0.f};
    const bf16_t* kg = (const bf16_t*)(p.ws + WS_BK) + ((size_t)b * TB) * 1024 + h * 128;
    const bf16_t* vg = (const bf16_t*)(p.ws + WS_BVT) + ((size_t)(b * 1024 + h * 128)) * TB;
    const int row0 = tid >> 4, cc = tid & 15;
    const bf16_t* kgp = kg + (size_t)row0 * 1024 + cc * 8;
    const bf16_t* vgp = vg + (size_t)row0 * TB + cc * 8;
    const unsigned klo = krow_perm(row0) * KSTR + cc * 16;
    const unsigned vlo = 2 * KBUF + row0 * VSTR + cc * 16;
    u32x4 sk[4], sv[4];
#pragma unroll
    for (int i = 0; i < 4; ++i) { sk[i] = *(const u32x4*)(kgp + (size_t)(32 * i) * 1024); sv[i] = *(const u32x4*)(vgp + (size_t)(32 * i) * TB); }
#pragma unroll
    for (int i = 0; i < 4; ++i) { *(LAS u32x4*)(lds + klo + 32 * i * KSTR) = sk[i]; *(LAS u32x4*)(lds + vlo + 32 * i * VSTR) = sv[i]; }
    __syncthreads();
    for (int t = 0; t < nkt; ++t) {
        const int cur = t & 1;
        const bool pf = (t + 1 < nkt);
        if (pf) { const size_t ko = (size_t)(t + 1) * 128;
#pragma unroll
            for (int i = 0; i < 4; ++i) { sk[i] = *(const u32x4*)(kgp + (ko + 32 * i) * 1024); sv[i] = *(const u32x4*)(vgp + (size_t)(32 * i) * TB + ko); } }
        const LAS unsigned char* Kb = lds + cur * KBUF + mp * 128;
        const LAS unsigned char* Vb = lds + 2 * KBUF + cur * VBUF;
#pragma unroll
        for (int hh = 0; hh < 2; ++hh) {
            bf16x8 pfr[2][2];
#pragma unroll
            for (int g2 = 0; g2 < 2; ++g2) {
                f32x4 S[2][2];
#pragma unroll
                for (int tt = 0; tt < 2; ++tt) { S[0][tt] = (f32x4){0.f, 0.f, 0.f, 0.f}; S[1][tt] = S[0][tt];
#pragma unroll
                    for (int s = 0; s < 2; ++s) { const bf16x8 kf = *(const LAS bf16x8*)(Kb + (64 * hh + 16 * (2 * g2 + tt) + fr) * KSTR + s * 64 + fg * 16);
                        S[0][tt] = MFMA16(kf, qf[0][s], S[0][tt]); S[1][tt] = MFMA16(kf, qf[1][s], S[1][tt]); } }
#pragma unroll
                for (int qg = 0; qg < 2; ++qg) { float ps = 0.f;
#pragma unroll
                    for (int tt = 0; tt < 2; ++tt)
#pragma unroll
                        for (int i = 0; i < 4; ++i) { S[qg][tt][i] = __builtin_amdgcn_exp2f(SHIFT ? S[qg][tt][i] - mb : S[qg][tt][i]); ps += S[qg][tt][i]; }
                    lsum[qg] += ps;
                    u32x4 wv; wv[0] = cvtpk_m(S[qg][0][0], S[qg][0][1]); wv[1] = cvtpk_m(S[qg][0][2], S[qg][0][3]); wv[2] = cvtpk_m(S[qg][1][0], S[qg][1][1]); wv[3] = cvtpk_m(S[qg][1][2], S[qg][1][3]);
                    pfr[qg][g2] = *reinterpret_cast<bf16x8*>(&wv); } }
#pragma unroll
            for (int D = 0; D < 8; ++D)
#pragma unroll
                for (int g2 = 0; g2 < 2; ++g2) { const bf16x8 vf = *(const LAS bf16x8*)(Vb + (16 * D + fr) * VSTR + (64 * hh + 32 * g2 + 8 * fg) * 2);
                    O[0][D] = MFMA16(vf, pfr[0][g2], O[0][D]); O[1][D] = MFMA16(vf, pfr[1][g2], O[1][D]); }
        }
        if (pf) { const unsigned o = (cur ^ 1);
#pragma unroll
            for (int i = 0; i < 4; ++i) { *(LAS u32x4*)(lds + o * KBUF + klo + 32 * i * KSTR) = sk[i]; *(LAS u32x4*)(lds + o * VBUF + vlo + 32 * i * VSTR) = sv[i]; } }
        __syncthreads();
    }
#pragma unroll
    for (int qg = 0; qg < 2; ++qg) { lsum[qg] += __shfl_xor(lsum[qg], 16); lsum[qg] += __shfl_xor(lsum[qg], 32); }
    const float cmy = mp == 0 ? 1.f : -lam;
    const float sc0 = cmy / lsum[0], sc1 = cmy / lsum[1];
    LAS f32x4* xch = (LAS f32x4*)lds;
#pragma unroll
    for (int D = 0; D < 8; ++D) { const f32x4 give = mp == 0 ? O[1][D] * sc1 : O[0][D] * sc0; xch[(w * 8 + D) * 64 + lane] = give; }
    __syncthreads();
    float ss = 0.f;
#pragma unroll
    for (int D = 0; D < 8; ++D) { const f32x4 got = xch[((w ^ 1) * 8 + D) * 64 + lane]; const f32x4 mine = mp == 0 ? O[0][D] * sc0 : O[1][D] * sc1;
        O[0][D] = mine + got;
#pragma unroll
        for (int i = 0; i < 4; ++i) ss += O[0][D][i] * O[0][D][i]; }
    ss += __shfl_xor(ss, 16); ss += __shfl_xor(ss, 32);
    const float rinv = rsqrtf(ss * (1.f / 128.f) + EPS) * (1.f - lam_init);
    bf16_t* bz = (bf16_t*)(p.ws + WS_BZ) + ((size_t)(b * TB + q0 + 32 * pr + 16 * mp + fr)) * 1024 + h * 128;
    const float* sw = p.in[16] + l * 128;
#pragma unroll
    for (int D = 0; D < 8; ++D) { const int dv = 16 * D + 4 * fg;
        const u32x2 z = *(const u32x2*)(bz + dv); const f32x4 wv = *(const f32x4*)(sw + dv);
        const float y0 = O[0][D][0] * rinv * wv[0] * silu(bf_lo(z[0])), y1 = O[0][D][1] * rinv * wv[1] * silu(bf_hi(z[0]));
        const float y2 = O[0][D][2] * rinv * wv[2] * silu(bf_lo(z[1])), y3 = O[0][D][3] * rinv * wv[3] * silu(bf_hi(z[1]));
        u32x2 o; o[0] = cvtpk(y0, y1); o[1] = cvtpk(y2, y3); *(u32x2*)(bz + dv) = o; }
    __syncthreads();
}
__device__ __forceinline__ void attn_item(const Params& p, LAS unsigned char* lds, int l, int b, int h, int q0, int nkt) {
    const int lane = threadIdx.x & 63;
    const float mbw = 8.f * wave_max(fabsf(p.in[10][l * 64 + lane])) * wave_max(fabsf(p.in[11][l * 64 + lane])) * LOG2E;
    if (__builtin_amdgcn_readfirstlane(mbw < 64.f ? 1 : 0)) attn_body<false>(p, lds, l, b, h, q0, nkt);
    else attn_body<true>(p, lds, l, b, h, q0, nkt);
}

__device__ __forceinline__ void mlstm_item(const Params& p, LAS unsigned char* lds, int item) {
    const int tid = tid_opaque(), w = tid >> 6, lane = tid & 63, fr = lane & 15, fg = lane >> 4;
    const int sl = item & 1, dir = (item >> 1) & 1, h = (item >> 2) & 3, b = item >> 4;
    constexpr int S272 = 272, S144 = 144;
    constexpr int OQ = 0, OK_ = 17408, OKT = 34816, OVT = 53248, OA = 71680, OCT = 80896, OVEC = 115712;
    LAS unsigned char* QS = lds + OQ; LAS unsigned char* KS = lds + OK_; LAS unsigned char* KT = lds + OKT;
    LAS unsigned char* VT = lds + OVT; LAS unsigned char* AS = lds + OA; LAS unsigned char* CT = lds + OCT;
    LAS float* ve = (LAS float*)(lds + OVEC);
    LAS float* vM = ve + 64;
    LAS float* vwi = ve + 128;
    LAS float* vwk = ve + 192;
    LAS float* vemr = ve + 256;
    LAS float* vden = ve + 320;
    LAS float* vn = ve + 384;
    LAS float* vsc = ve + 640;
    const bf16_t* AQ = (const bf16_t*)(p.ws + WS_AQ) + (size_t)b * TB * 512 + h * 128;
    const bf16_t* AK = (const bf16_t*)(p.ws + WS_AK) + (size_t)b * TB * 512 + h * 128;
    const bf16_t* AKT = (const bf16_t*)(p.ws + WS_AKT) + ((size_t)b * 512 + h * 128) * TB;
    const bf16_t* AVT = (const bf16_t*)(p.ws + WS_AVT) + ((size_t)b * 1024 + h * 256 + sl * 128) * TB;
    const float* GT = (const float*)(p.ws + WS_GATES) + (size_t)b * TB * 16 + (dir * 2) * 4 + h;
    bf16_t* HO = (bf16_t*)(p.ws + (dir ? WS_HB : WS_HF)) + (size_t)b * TB * 1024 + h * 256 + sl * 128;
    for (int i = tid; i < 128 * S272 / 4; i += 512) ((LAS unsigned*)CT)[i] = 0u;
    if (tid < 256) vn[tid] = 0.f;
    f32x4 cst[8];
#pragma unroll
    for (int i = 0; i < 8; ++i) cst[i] = (f32x4){0.f, 0.f, 0.f, 0.f};
    float m_st = 0.f;
    const int qr0 = tid >> 4, qcc = tid & 15;
    const int tr0 = tid >> 3, tcc = tid & 7;
    auto chunk_tb0 = [&](int c) -> int { return dir == 0 ? 64 * c : (c < 4 ? 256 - 64 * (c + 1) : 4352 - 64 * (c - 3)); };
    u32x4 gq0, gq1, gk0, gk1, gt0, gt1, gv0, gv1; float gig = 0.f, glf = 0.f;
    auto issue = [&](int c) {
        const int tb0 = chunk_tb0(c);
        gq0 = *(const u32x4*)(AQ + (size_t)(tb0 + qr0) * 512 + qcc * 8); gq1 = *(const u32x4*)(AQ + (size_t)(tb0 + qr0 + 32) * 512 + qcc * 8);
        gk0 = *(const u32x4*)(AK + (size_t)(tb0 + qr0) * 512 + qcc * 8); gk1 = *(const u32x4*)(AK + (size_t)(tb0 + qr0 + 32) * 512 + qcc * 8);
        gt0 = *(const u32x4*)(AKT + (size_t)tr0 * TB + tb0 + tcc * 8); gt1 = *(const u32x4*)(AKT + (size_t)(tr0 + 64) * TB + tb0 + tcc * 8);
        gv0 = *(const u32x4*)(AVT + (size_t)tr0 * TB + tb0 + tcc * 8); gv1 = *(const u32x4*)(AVT + (size_t)(tr0 + 64) * TB + tb0 + tcc * 8);
        if (w == 0) { gig = GT[(size_t)(tb0 + lane) * 16]; glf = GT[(size_t)(tb0 + lane) * 16 + 4]; }
    };
    auto commit = [&]() {
        *(LAS u32x4*)(QS + qr0 * S272 + qcc * 16) = gq0; *(LAS u32x4*)(QS + (qr0 + 32) * S272 + qcc * 16) = gq1;
        *(LAS u32x4*)(KS + qr0 * S272 + qcc * 16) = gk0; *(LAS u32x4*)(KS + (qr0 + 32) * S272 + qcc * 16) = gk1;
        *(LAS u32x4*)(KT + tr0 * S144 + tcc * 16) = gt0; *(LAS u32x4*)(KT + (tr0 + 64) * S144 + tcc * 16) = gt1;
        *(LAS u32x4*)(VT + tr0 * S144 + tcc * 16) = gv0; *(LAS u32x4*)(VT + (tr0 + 64) * S144 + tcc * 16) = gv1;
    };
    issue(0); commit();
    float ig_c = gig, lf_c = glf;
    __syncthreads();
    for (int c = 0; c < 68; ++c) {
        const int tb0 = chunk_tb0(c);
        const int np = c & 1;
        if (c + 1 < 68) issue(c + 1);
        if (w == 0) {
            float bcum = lf_c, e;
            if (dir == 0) {
#pragma unroll
                for (int o = 1; o < 64; o <<= 1) { const float t = __shfl_up(bcum, o); if (lane >= o) bcum += t; }
            } else {
#pragma unroll
                for (int o = 1; o < 64; o <<= 1) { const float t = __shfl_down(bcum, o); if (lane + o < 64) bcum += t; }
            }
            e = ig_c - bcum;
            float cm = e;
            if (dir == 0) {
#pragma unroll
                for (int o = 1; o < 64; o <<= 1) { const float t = __shfl_up(cm, o); if (lane >= o) cm = fmaxf(cm, t); }
            } else {
#pragma unroll
                for (int o = 1; o < 64; o <<= 1) { const float t = __shfl_down(cm, o); if (lane + o < 64) cm = fmaxf(cm, t); }
            }
            const int lastl = dir == 0 ? 63 : 0;
            const float btot = __shfl(bcum, lastl), emax = __shfl(cm, lastl);
            const float Mv = fmaxf(cm, m_st);
            const float E = fmaxf(m_st, emax);
            ve[lane] = e; vM[lane] = Mv; vwi[lane] = __expf(m_st - Mv); vemr[lane] = __expf(-(bcum + Mv)); vwk[lane] = __expf(e - E);
            if (lane == 0) vsc[0] = __expf(m_st - E);
            m_st = btot + E;
            ig_c = gig; lf_c = glf;
        }
        f32x4 st[2];
        { const int sm = w >> 1, tn0 = 2 * (w & 1);
          st[0] = (f32x4){0.f, 0.f, 0.f, 0.f}; st[1] = st[0];
#pragma unroll
          for (int ks = 0; ks < 4; ++ks) { const bf16x8 af = *(const LAS bf16x8*)(KS + (16 * sm + fr) * S272 + ks * 64 + fg * 16);
#pragma unroll
              for (int j = 0; j < 2; ++j) { const bf16x8 bfr = *(const LAS bf16x8*)(QS + (16 * (tn0 + j) + fr) * S272 + ks * 64 + fg * 16); st[j] = MFMA16(af, bfr, st[j]); } } }
        __syncthreads();
        { const int sm = w >> 1, tn0 = 2 * (w & 1);
#pragma unroll
          for (int j = 0; j < 2; ++j) { const int t = 16 * (tn0 + j) + fr; const float Mt = vM[t]; float v[4];
#pragma unroll
              for (int i = 0; i < 4; ++i) { const int s = 16 * sm + 4 * fg + i; const bool ok = dir == 0 ? (s <= t) : (s >= t);
                  const float f = __expf(ve[s] - Mt); v[i] = ok ? st[j][i] * f : 0.f; }
              u32x2 o; o[0] = cvtpk(v[0], v[1]); o[1] = cvtpk(v[2], v[3]);
              *(LAS u32x2*)(AS + t * S144 + (16 * sm + 4 * fg) * 2) = o; } }
        { const int dk = tid >> 2, seg = tid & 3; LAS unsigned char* rowp = KT + dk * S144 + seg * 32;
          u32x4 a = *(LAS u32x4*)rowp, bb = *(LAS u32x4*)(rowp + 16); float sum = 0.f;
#pragma unroll
          for (int q = 0; q < 4; ++q) { const int s = seg * 16 + 2 * q; const float x0 = bf_lo(a[q]) * vwk[s], x1 = bf_hi(a[q]) * vwk[s + 1]; a[q] = cvtpk(x0, x1); sum += bf_lo(a[q]) + bf_hi(a[q]); }
#pragma unroll
          for (int q = 0; q < 4; ++q) { const int s = seg * 16 + 8 + 2 * q; const float x0 = bf_lo(bb[q]) * vwk[s], x1 = bf_hi(bb[q]) * vwk[s + 1]; bb[q] = cvtpk(x0, x1); sum += bf_lo(bb[q]) + bf_hi(bb[q]); }
          *(LAS u32x4*)rowp = a; *(LAS u32x4*)(rowp + 16) = bb;
          sum += __shfl_xor(sum, 1); sum += __shfl_xor(sum, 2);
          if (seg == 0) vn[(np ^ 1) * 128 + dk] = vsc[0] * vn[np * 128 + dk] + sum; }
        __syncthreads();
        { const int t = tid >> 3, part = tid & 7;
          const u32x4 a = *(const LAS u32x4*)(AS + t * S144 + part * 16);
          float ds = 0.f;
#pragma unroll
          for (int q = 0; q < 4; ++q) ds += bf_lo(a[q]) + bf_hi(a[q]);
          const u32x4 q0 = *(const LAS u32x4*)(QS + t * S272 + part * 32), q1 = *(const LAS u32x4*)(QS + t * S272 + part * 32 + 16);
          const LAS float* nn = vn + np * 128 + part * 16; float qn = 0.f;
#pragma unroll
          for (int q = 0; q < 4; ++q) { qn += bf_lo(q0[q]) * nn[2 * q] + bf_hi(q0[q]) * nn[2 * q + 1]; qn += bf_lo(q1[q]) * nn[8 + 2 * q] + bf_hi(q1[q]) * nn[8 + 2 * q + 1]; }
          ds += __shfl_xor(ds, 1); ds += __shfl_xor(ds, 2); ds += __shfl_xor(ds, 4);
          qn += __shfl_xor(qn, 1); qn += __shfl_xor(qn, 2); qn += __shfl_xor(qn, 4);
          if (part == 0) vden[t] = ds + vwi[t] * qn; }
        f32x4 n1[4], n2[4];
        {
#pragma unroll
          for (int j = 0; j < 4; ++j) { n1[j] = (f32x4){0.f, 0.f, 0.f, 0.f}; n2[j] = n1[j]; }
#pragma unroll
          for (int ks = 0; ks < 2; ++ks) { const bf16x8 af = *(const LAS bf16x8*)(VT + (16 * w + fr) * S144 + ks * 64 + fg * 16);
#pragma unroll
              for (int j = 0; j < 4; ++j) { const bf16x8 bfr = *(const LAS bf16x8*)(AS + (16 * j + fr) * S144 + ks * 64 + fg * 16); n1[j] = MFMA16(af, bfr, n1[j]); } }
#pragma unroll
          for (int ks = 0; ks < 4; ++ks) { const bf16x8 af = *(const LAS bf16x8*)(CT + (16 * w + fr) * S272 + ks * 64 + fg * 16);
#pragma unroll
              for (int j = 0; j < 4; ++j) { const bf16x8 bfr = *(const LAS bf16x8*)(QS + (16 * j + fr) * S272 + ks * 64 + fg * 16); n2[j] = MFMA16(af, bfr, n2[j]); } } }
        { const float decay = vsc[0];
#pragma unroll
          for (int dn = 0; dn < 8; ++dn) cst[dn] *= decay;
#pragma unroll
          for (int ks = 0; ks < 2; ++ks) { const bf16x8 af = *(const LAS bf16x8*)(KT + (16 * w + fr) * S144 + ks * 64 + fg * 16);
#pragma unroll
              for (int dn = 0; dn < 8; ++dn) { const bf16x8 bfr = *(const LAS bf16x8*)(VT + (16 * dn + fr) * S144 + ks * 64 + fg * 16); cst[dn] = MFMA16(af, bfr, cst[dn]); } } }
        __syncthreads();
        {
#pragma unroll
          for (int j = 0; j < 4; ++j) { const int t = 16 * j + fr; const float wi = vwi[t]; const float dinv = 1.f / fmaxf(fabsf(vden[t]), vemr[t]);
              const float h0 = (n1[j][0] + wi * n2[j][0]) * dinv, h1 = (n1[j][1] + wi * n2[j][1]) * dinv, h2 = (n1[j][2] + wi * n2[j][2]) * dinv, h3 = (n1[j][3] + wi * n2[j][3]) * dinv;
              u32x2 o; o[0] = cvtpk(h0, h1); o[1] = cvtpk(h2, h3);
              __hip_atomic_store((unsigned long long*)(HO + (size_t)(tb0 + t) * 1024 + 16 * w + 4 * fg), ((unsigned long long)o[1] << 32) | o[0], __ATOMIC_RELAXED, __HIP_MEMORY_SCOPE_AGENT); } }
#pragma unroll
        for (int dn = 0; dn < 8; ++dn) { u32x2 o; o[0] = cvtpk(cst[dn][0], cst[dn][1]); o[1] = cvtpk(cst[dn][2], cst[dn][3]);
            *(LAS u32x2*)(CT + (16 * dn + fr) * S272 + (16 * w + 4 * fg) * 2) = o; }
        if (c + 1 < 68) commit();
        __syncthreads();
    }
}

__device__ __forceinline__ void mlstm_out_rows(const Params& p, int l, int r0, int nrows) {
    const int tid = tid_opaque(), lane = tid & 63, w = tid >> 6;
    const float* anw = p.in[9] + (size_t)l * 1024 + lane * 16;
    float wv[16];
#pragma unroll
    for (int j = 0; j < 16; ++j) wv[j] = anw[j];
    for (int r = r0 + w; r < r0 + nrows; r += 8) {
        const size_t o = (size_t)r * 1024 + lane * 16;
        const bf16_t* hf = (const bf16_t*)(p.ws + WS_HF) + o; const bf16_t* hb = (const bf16_t*)(p.ws + WS_HB) + o;
        bf16_t* ao = (bf16_t*)(p.ws + WS_AO) + o; const bf16_t* az = (const bf16_t*)(p.ws + WS_AZ) + o;
        float v[16]; float ss = 0.f;
#pragma unroll
        for (int hh = 0; hh < 2; ++hh) { const u32x4 a = *(const u32x4*)(hf + 8 * hh), bb = *(const u32x4*)(hb + 8 * hh);
#pragma unroll
            for (int q = 0; q < 4; ++q) { v[8 * hh + 2 * q] = bf_lo(a[q]) + bf_lo(bb[q]); v[8 * hh + 2 * q + 1] = bf_hi(a[q]) + bf_hi(bb[q]); } }
#pragma unroll
        for (int j = 0; j < 16; ++j) ss += v[j] * v[j];
        ss += __shfl_xor(ss, 1); ss += __shfl_xor(ss, 2); ss += __shfl_xor(ss, 4); ss += __shfl_xor(ss, 8);
        const float rinv = rsqrtf(ss * (1.f / 256.f) + EPS);
#pragma unroll
        for (int hh = 0; hh < 2; ++hh) { const u32x4 a = *(const u32x4*)(ao + 8 * hh), z = *(const u32x4*)(az + 8 * hh); u32x4 oo;
#pragma unroll
            for (int q = 0; q < 4; ++q) { const int j = 8 * hh + 2 * q;
                const float y0 = (v[j] * rinv) * wv[j] * sigm(bf_lo(a[q])) * silu(bf_lo(z[q]));
                const float y1 = (v[j + 1] * rinv) * wv[j + 1] * sigm(bf_hi(a[q])) * silu(bf_hi(z[q]));
                oo[q] = cvtpk(y0, y1); }
            *(u32x4*)(ao + 8 * hh) = oo; }
    }
}

extern __shared__ __attribute__((aligned(16))) unsigned char dyn_lds[];

__global__ void __launch_bounds__(NTHREADS) mega_fwd(const Params p0) {
    typedef const Params __attribute__((address_space(4))) * KP;
    KP kp = (KP)__builtin_amdgcn_kernarg_segment_ptr();
#define P (*(const Params*)kp)
#define LAUNDER() do { KP _k = (KP)__builtin_amdgcn_kernarg_segment_ptr(); asm volatile("" : "+s"(_k)); kp = _k; } while (0)
    cg::grid_group grid = cg::this_grid();
    LAS unsigned char* lds = (LAS unsigned char*)dyn_lds;
    volatile LAS unsigned* st = (volatile LAS unsigned*)(lds + LDS_BYTES - 16);
    if (threadIdx.x == 0) { st[0] = 0u; st[1] = 0u; st[2] = 0u; st[3] = 0u; }
    __syncthreads();
    unsigned* ctl = (unsigned*)(P.ws + WS_CTL);
    XcdBarrier xb = xcd_barrier_post(ctl, st);
    const int G = gridDim.x, bid = blockIdx.x, tid = threadIdx.x;

    phase0(P, lds);
    grid.sync();

#pragma unroll 1
    for (int l = 0; l < DEPTH; ++l) {
        const bool last = (l == DEPTH - 1);
        LAUNDER();
        phase_prenorm(P, lds, l);
        LAUNDER();
        if (l > 0) { for (int item = bid; item < N_CONV_ITEMS; item += G) convert_item(P, lds, l, item); }
        xcd_barrier(xb);
        LAUNDER();
        { SchedNat S{(const char*)(P.ws + WS_H), (const char*)(P.ws + WS_WNAT), G, bid}; EpiNat E{P.ws};
          gemm_phase<true, true>(lds, 1024, 2048u, 2048u, S, E); }
        LAUNDER();
        { SchedTr S{(const char*)(P.ws + WS_H), (const char*)(P.ws + WS_WTR), G, bid}; EpiTr E{P.ws};
          gemm_phase<true, true>(lds, 1024, 2048u, 2048u, S, E); }
        xcd_barrier(xb);
        LAUNDER();
        phase_qkprep(P, lds, l);
        LAUNDER();
        { SchedF1L S{(const char*)(P.ws + WS_T2A), (const char*)(P.ws + WS_CU), G, bid}; EpiF1L E{P.ws};
          gemm_phase(lds, 256, 512u, 2048u, S, E); }
        LAUNDER();
        { SchedF1C S{(const char*)(P.ws + WS_T2A), (const char*)(P.ws + WS_CU), G, G - 1 - bid}; EpiF1C E{P.ws};
          gemm_phase(lds, 256, 512u, 2048u, S, E); }
        xcd_barrier(xb);
        LAUNDER();
        {
            { SchedFA S{(const char*)(P.ws + WS_ZTL), (const char*)(P.ws + WS_F2T), G, bid}; EpiFA E{P.ws};
              gemm_phase<true, false>(lds, 128, 256u, 256u, S, E); }
            unsigned* cb = ctl + 12288 + 1024 * l;
            unsigned* fa_done = cb; unsigned* ml_done = cb + 64; unsigned* ctxf_done = cb + 128; unsigned* ctxa_done = cb + 192; unsigned* ctxo_done = cb + 256; unsigned* ctxm_done = cb + 320;
            publish_add_wt(fa_done);
            LAUNDER();
            unsigned* counter = ctl + 4096 + 64 * l;
            const int nc = last ? 0 : 1;
            const int e0 = 64, e1 = e0 + 16 * nc, e2 = e1 + 64 * nc, e3 = e2 + 640, e4 = e3 + 16 * nc, e5 = e4 + 16 * nc, e6 = e5 + 16 * nc, e7 = e6 + 384, e8 = e7 + 256, e9 = e8 + 256;
            for (;;) {
                __syncthreads();
                if (tid == 0) st[2] = atomicAdd(counter, 1u);
                __syncthreads();
                const int item = (int)st[2];
                LAUNDER();
                if (item >= e9) break;
                if (item < e0) { mlstm_item(P, lds, item); publish_add_wt(ml_done); continue; }
                if (item < e1) { const int it = item - e0, pn = it & 3, b = it >> 2;
                    SchedOne S; S.u0.pm = 0; S.u0.pn = pn; S.u0.aux = b * TB;
                    S.u0.a = (const char*)(P.ws + WS_T2B); S.u0.b = (const char*)(P.ws + WS_ZTC) + ((size_t)b * 1024 + pn * 256) * 1024;
                    EpiF2 E{P.ws, 1.f / 256.f};
                    gemm_phase(lds, 512, 1024u, 1024u, S, E); publish_add(ctxf_done); continue; }
                if (item < e2) { const int it = item - e1, qb = it & 1, h = (it >> 1) & 7, b = it >> 4; attn_item(P, lds, l, b, h, 128 * qb, 2); publish_add(ctxa_done); continue; }
                if (item < e3 || (item >= e6 && item < e7)) { const int it = item < e3 ? item - e2 : 640 + (item - e6); const int qb = it & 31, h = (it >> 5) & 7, b = it >> 8;
                    attn_item(P, lds, l, b, h, 256 + 128 * qb, 34); continue; }
                if (item < e4) { const int it = item - e3; wait_count(ml_done, 64u); mlstm_out_rows(P, l, (it >> 2) * TB + 64 * (it & 3), 64); publish_add(ctxo_done); continue; }
                if (item < e5) { const int it = item - e4, pn = it & 3, b = it >> 2;
                    wait_count(ctxf_done, 16u); wait_count(ctxa_done, 64u); wait_count(ctxo_done, 16u);
                    SchedM1Cq S{(const char*)P.ws, 17 * b, pn}; EpiM1C E{P.ws};
                    gemm_phase<true, true>(lds, 1024, 2048u, 2048u, S, E); publish_add(ctxm_done + 64 * b); continue; }
                if (item < e6) { const int it = item - e5, pn = it & 3, b = it >> 2;
                    wait_count(ctxm_done + 64 * b, 4u);
                    SchedOne S; S.u0.pm = 17 * b; S.u0.pn = pn; S.u0.aux = 0;
                    S.u0.a = (const char*)(P.ws + WS_H) + (size_t)(17 * b) * 256 * 2048; S.u0.b = (const char*)(P.ws + WS_WOUT + 3 * 2097152) + (size_t)pn * 256 * 2048;
                    EpiM2 E{l == 0 ? P.in[0] : P.out, l == 0 ? P.in[2] : (const float*)(P.ws + WS_CTXS), P.out, (float*)(P.ws + WS_CTXS), (const float*)(P.ws + WS_MOD) + (size_t)l * 5 * 3072};
                    gemm_phase(lds, 1024, 2048u, 2048u, S, E); continue; }
                if (item < e8) { const int it = item - e7;
                    wait_count(ml_done, 64u); mlstm_out_rows(P, l, (it >> 6) * TB + 256 + 64 * (it & 63), 64); continue; }
                { const int it = item - e8; wait_count(fa_done, (unsigned)G);
                  SchedFB S{(const char*)(P.ws + WS_G2T), (const char*)(P.ws + WS_T1), 4 * it}; EpiFB E{P.ws};
                  gemm_phase<true, false>(lds, 128, 256u, 256u, S, E); }
            }
        }
        xcd_barrier(xb);
        LAUNDER();
        { SchedM1C S{(const char*)P.ws, G, bid, 1}; EpiM1C E{P.ws}; gemm_phase<true, true>(lds, 1024, 2048u, 2048u, S, E); }
        xcd_barrier(xb);
        LAUNDER();
        { SchedM S{(const char*)(P.ws + WS_H), (const char*)(P.ws + WS_WOUT + 3 * 2097152), G, bid, 1};
          EpiM2 E{l == 0 ? P.in[0] : P.out, l == 0 ? P.in[2] : (const float*)(P.ws + WS_CTXS), P.out, (float*)(P.ws + WS_CTXS), (const float*)(P.ws + WS_MOD) + (size_t)l * 5 * 3072};
          gemm_phase(lds, 1024, 2048u, 2048u, S, E); }
        if (!last) xcd_barrier(xb);
    }
}

extern "C" void kernel_launch(void* const* d_in, const int* in_sizes, int n_in, void* d_out, int out_size,
                              void* d_ws, size_t ws_size, hipStream_t stream) {
    static int grid_blocks = 0;
    if (!grid_blocks) {
        int dev = 0, cus = 0, per_cu = 0;
        (void)hipGetDevice(&dev);
        (void)hipDeviceGetAttribute(&cus, hipDeviceAttributeMultiprocessorCount, dev);
        (void)hipFuncSetAttribute((const void*)mega_fwd, hipFuncAttributeMaxDynamicSharedMemorySize, LDS_BYTES);
        (void)hipOccupancyMaxActiveBlocksPerMultiprocessor(&per_cu, (const void*)mega_fwd, NTHREADS, LDS_BYTES);
        grid_blocks = cus;
        if (ws_size < WS_END || per_cu < 1) fprintf(stderr, "kernel_launch: ws %zu (need %zu), per_cu %d\n", ws_size, (size_t)WS_END, per_cu);
    }
    (void)hipMemsetAsync(d_ws, 0, 65536, stream);
    Params p{};
    for (int i = 0; i < 21 && i < n_in; ++i) p.in[i] = (const float*)d_in[i];
    p.out = (float*)d_out; p.ws = (unsigned char*)d_ws;
    void* args[] = {&p};
    hipError_t e = hipLaunchCooperativeKernel((const void*)mega_fwd, dim3(grid_blocks), dim3(NTHREADS), args, LDS_BYTES, stream);
    if (e != hipSuccess) fprintf(stderr, "cooperative launch failed: %s (grid %d)\n", hipGetErrorString(e), grid_blocks);
}
```

```cpp
#include <hip/hip_runtime.h>
#include <hip/hip_cooperative_groups.h>
#include <cstdio>
#include <cstdint>
namespace cg = cooperative_groups;

#define LAS __attribute__((address_space(3)))
typedef unsigned short bf16_t;
typedef short bf16x8 __attribute__((ext_vector_type(8)));
typedef float f32x4 __attribute__((ext_vector_type(4)));
typedef float f32x16 __attribute__((ext_vector_type(16)));
typedef unsigned u32x4 __attribute__((ext_vector_type(4)));
typedef unsigned u32x2 __attribute__((ext_vector_type(2)));

constexpr int NTHREADS = 512;
constexpr int LDS_BYTES = 144 * 1024;
constexpr int NB = 4, SEQ = 4096, CTXL = 256, TB = 4352, NTOK = NB * TB, DM = 1024, DIN = 13328, DEPTH = 4;
constexpr int NNAT = 11264, NTR = 2048;
constexpr float EPS = 1e-6f;
constexpr float LOG2E = 1.4426950408889634f;

constexpr size_t WS_CTL = 0;
constexpr size_t WS_MOD = 65536;
constexpr size_t WS_T2A = 311296;
constexpr size_t WS_T2B = 573440;
constexpr size_t WS_F2T = 835584;
constexpr size_t WS_G2T = 901120;
constexpr size_t WS_T1 = 1048576;
constexpr size_t WS_WNAT = 68157440;
constexpr size_t WS_WTR = 91226112;
constexpr size_t WS_WOUT = 96468992;
constexpr size_t WS_H = 104857600;
constexpr size_t WS_GATES = 140509184;
constexpr size_t WS_CTXS = 141623296;
constexpr size_t WS_AQ = 145817600;
constexpr size_t WS_AK = 163643392;
constexpr size_t WS_AKT = 181469184;
constexpr size_t WS_AVT = 199294976;
constexpr size_t WS_BVT = 234946560;
constexpr size_t WS_AO = 270598144;
constexpr size_t WS_AZ = 306249728;
constexpr size_t WS_BQ = 341901312;
constexpr size_t WS_BK = 377552896;
constexpr size_t WS_BZ = 413204480;
constexpr size_t WS_CU = 448856064;
constexpr size_t WS_CZ = 484507648;
constexpr size_t WS_MG = 520159232;
constexpr size_t WS_HF = 627113984;
constexpr size_t WS_HB = 662765568;
constexpr size_t WS_YMF = WS_HF;
constexpr size_t WS_ZTL = 698417152;
constexpr size_t WS_ZTC = 765526016;
constexpr size_t WS_END = 769720320;

#define XB_TMO      128
#define XB_XCNT(j)  (256  + 64 * (j))
#define XB_XSUB(j)  (1280 + 64 * (j))
#define XB_XGEN(j)  (2304 + 64 * (j))
#define XB_TOP      3328
#define XB_TOPGEN   3392
#define XCD_BAR_WORDS 3456
#define XB_SPIN_CAP (1u << 24)
__device__ __forceinline__ unsigned xb_ld(unsigned* p)              { return __hip_atomic_load(p, __ATOMIC_RELAXED, __HIP_MEMORY_SCOPE_AGENT); }
__device__ __forceinline__ unsigned xb_add(unsigned* p, unsigned v) { return __hip_atomic_fetch_add(p, v, __ATOMIC_RELAXED, __HIP_MEMORY_SCOPE_AGENT); }
__device__ __forceinline__ unsigned xb_xcc_id() { return (unsigned)__builtin_amdgcn_s_getreg((3 << 11) | 20) & 0xFu; }
#define XB_SPIN(cond, bar) do { unsigned _sp = 0; while (cond) { __builtin_amdgcn_s_sleep(1); \
    if ((++_sp & 255u) == 0u) { if (xb_ld(&(bar)[XB_TMO])) break; if (_sp > XB_SPIN_CAP) { atomicAdd(&(bar)[XB_TMO], 1u); break; } } } } while (0)
struct XcdBarrier { unsigned* bar; unsigned x; volatile LAS unsigned* st; };
__device__ __forceinline__ XcdBarrier xcd_barrier_post(unsigned* bar, volatile LAS unsigned* st) {
    XcdBarrier b; b.bar = bar; b.x = xb_xcc_id(); b.st = st;
    if (threadIdx.x == 0) (void)xb_add(&bar[XB_XCNT(b.x)], 1u);
    return b;
}
__device__ __forceinline__ void xcd_barrier_complete(unsigned* bar, unsigned x, unsigned& nloc, unsigned& nx) {
    const unsigned G = gridDim.x * gridDim.y * gridDim.z;
    unsigned sum, cnt, mine, sp = 0u;
    for (;;) {
        sum = 0u; cnt = 0u; mine = 0u;
#pragma unroll
        for (unsigned j = 0; j < 16; ++j) { const unsigned c = xb_ld(&bar[XB_XCNT(j)]); sum += c; cnt += (c > 0u) ? 1u : 0u; mine = (j == x) ? c : mine; }
        if (sum == G) break;
        __builtin_amdgcn_s_sleep(1);
        if ((++sp & 255u) == 0u) { if (xb_ld(&bar[XB_TMO])) break; if (sp > XB_SPIN_CAP) { atomicAdd(&bar[XB_TMO], 1u); break; } }
    }
    nloc = mine > 0u ? mine : 1u; nx = cnt > 0u ? cnt : 1u;
}
__device__ __forceinline__ void xcd_barrier(const XcdBarrier& b) {
    asm volatile("s_waitcnt vmcnt(0)" ::: "memory");
    __syncthreads();
    if (threadIdx.x == 0) {
        unsigned* bar = b.bar;
        __builtin_amdgcn_s_waitcnt(0);
        unsigned nloc = b.st[0], nx = b.st[1];
        if (nloc == 0u) { xcd_barrier_complete(bar, b.x, nloc, nx); b.st[0] = nloc; b.st[1] = nx; }
        const unsigned old = xb_add(&bar[XB_XSUB(b.x)], 1u);
        const unsigned gen = old / nloc;
        if (old + 1u == (gen + 1u) * nloc) {
            __builtin_amdgcn_fence(__ATOMIC_RELEASE, "agent");
            asm volatile("s_waitcnt vmcnt(0)" ::: "memory");
            const unsigned og = xb_add(&bar[XB_TOP], 1u);
            const unsigned tg = og / nx;
            if (og + 1u == (tg + 1u) * nx) xb_add(&bar[XB_TOPGEN], 1u);
            else XB_SPIN(xb_ld(&bar[XB_TOPGEN]) == tg, bar);
            __builtin_amdgcn_fence(__ATOMIC_ACQUIRE, "agent");
            xb_add(&bar[XB_XGEN(b.x)], 1u);
            asm volatile("s_waitcnt vmcnt(0)" ::: "memory");
        } else {
            XB_SPIN(xb_ld(&bar[XB_XGEN(b.x)]) == gen, bar);
            __builtin_amdgcn_fence(__ATOMIC_ACQUIRE, "agent");
            asm volatile("s_waitcnt vmcnt(0)" ::: "memory");
        }
    }
    __syncthreads();
}

__device__ __forceinline__ void publish_add(unsigned* ctr) {
    asm volatile("s_waitcnt vmcnt(0)" ::: "memory");
    __syncthreads();
    if (threadIdx.x == 0) { __builtin_amdgcn_fence(__ATOMIC_RELEASE, "agent"); asm volatile("s_waitcnt vmcnt(0)" ::: "memory"); (void)xb_add(ctr, 1u); }
}
__device__ __forceinline__ void publish_add_wt(unsigned* ctr) {
    asm volatile("s_waitcnt vmcnt(0)" ::: "memory");
    __syncthreads();
    if (threadIdx.x == 0) (void)xb_add(ctr, 1u);
}
__device__ __forceinline__ void wait_count(unsigned* ctr, unsigned need) {
    if (threadIdx.x == 0) { unsigned sp = 0; while (xb_ld(ctr) < need) { __builtin_amdgcn_s_sleep(2); if (++sp > (1u << 26)) break; }
        __builtin_amdgcn_fence(__ATOMIC_ACQUIRE, "agent"); asm volatile("s_waitcnt vmcnt(0)" ::: "memory"); }
    __syncthreads();
}

__device__ __forceinline__ unsigned cvtpk(float lo, float hi) { unsigned r; asm("s_nop 1\n\tv_cvt_pk_bf16_f32 %0, %1, %2" : "=v"(r) : "v"(lo), "v"(hi)); return r; }
__device__ __forceinline__ unsigned cvtpk_m(float lo, float hi) { unsigned r; asm("s_nop 1\n\tv_cvt_pk_bf16_f32 %0, %1, %2\n\ts_nop 1" : "=v"(r) : "v"(lo), "v"(hi)); return r; }
__device__ __forceinline__ float bf_lo(unsigned w) { return __uint_as_float(w << 16); }
__device__ __forceinline__ float bf_hi(unsigned w) { return __uint_as_float(w & 0xffff0000u); }
__device__ __forceinline__ float sigm(float x) { return 1.f / (1.f + __expf(-x)); }
__device__ __forceinline__ float silu(float x) { return x / (1.f + __expf(-x)); }
__device__ __forceinline__ float wave_sum(float v) {
#pragma unroll
    for (int o = 32; o > 0; o >>= 1) v += __shfl_xor(v, o);
    return v;
}
__device__ __forceinline__ float wave_max(float v) {
#pragma unroll
    for (int o = 32; o > 0; o >>= 1) v = fmaxf(v, __shfl_xor(v, o));
    return v;
}

__device__ __forceinline__ int tid_opaque() { int t = threadIdx.x; asm volatile("" : "+v"(t)); return t; }

struct Params {
    const float* in[21];
    float* out;
    unsigned char* ws;
};

constexpr int BM = 256, BK = 64, HALF = 128, HTB = HALF * BK * 2, STAGE_BYTES = 8 * HTB;
__device__ __forceinline__ int lds_byte(int r, int c) { const int st = (r >> 4) * 2 + (c >> 5), rr = r & 15, cc = c & 31, ob = rr * 64 + cc * 2; return st * 1024 + (ob ^ (((ob >> 9) & 1) << 5)); }
__device__ __forceinline__ void stage_rc(int b, int& R, int& C) { const int st = b / 1024, sb = b % 1024, swz = sb ^ (((sb >> 9) & 1) << 5); R = (st >> 1) * 16 + swz / 64; C = (st & 1) * 32 + (swz % 64) / 2; }
__device__ __forceinline__ int perm32(int rho) { const int n = rho >> 4, i = rho & 15; return 8 * (i >> 2) + 4 * n + (i & 3); }

struct Unit { int pm, pn, aux; const char* a; const char* b; };

__device__ __forceinline__ bool tile_order(long L, int nM, int nN, int& pm, int& pn) {
    const int nwg = nM * nN; if (L >= nwg) return false;
    int wgid = (int)L; { const int q = nwg / 8, r = nwg % 8, xcd = wgid % 8, off = wgid / 8; wgid = (xcd < r ? xcd * (q + 1) : r * (q + 1) + (xcd - r) * q) + off; }
    const int nig = 8 * nN, gid = wgid / nig, fm = gid * 8, gsz = (nM - fm) < 8 ? (nM - fm) : 8;
    pm = fm + ((wgid % nig) % gsz); pn = (wgid % nig) / gsz; return true;
}

template <bool ALIGN_EPI = false, bool SP2 = false, class Epi, class Sched>
__device__ __forceinline__ void gemm_phase(LAS unsigned char* lds, const int K, const unsigned lda, const unsigned ldb, const Sched& S, const Epi& E) {
    const int tid = tid_opaque(), wid = __builtin_amdgcn_readfirstlane(tid >> 6), lane = tid & 63, wr = wid >> 2, wc = wid & 3, fr = lane & 15, fq = lane >> 4;
    const int nt = K / BK;
    unsigned voffA[2], voffB[2];
#pragma unroll
    for (int i = 0; i < 2; ++i) { int R, C; stage_rc(tid * 16 + i * 8192, R, C); const int Rb = Epi::PERM ? ((R & ~31) + perm32(R & 31)) : R;
        voffA[i] = (unsigned)R * lda + (unsigned)C * 2u; voffB[i] = (unsigned)Sched::bmap(Rb) * ldb + (unsigned)C * 2u; }
    const size_t kstep = (size_t)(BK * 2);
    const size_t hstepA = (size_t)HALF * lda, hstepB = (size_t)Sched::BHALF_ROWS * ldb;
    const unsigned ldsw = (unsigned)wid * 1024u;
    const int aoff = lds_byte(wr * 64 + fr, fq * 8), boff = lds_byte(wc * 32 + fr, fq * 8);
#define PG8_SA(b, h) (((b) * 2 + (h)) * HTB)
#define PG8_SB(b, h) ((4 + (b) * 2 + (h)) * HTB)
#define PG8_STAGE(bufoff, gbase, voff) do { _Pragma("unroll") for (int _i = 0; _i < 2; ++_i) \
        __builtin_amdgcn_global_load_lds((const unsigned*)((const char*)(gbase) + (voff)[_i]), (LAS unsigned*)(lds + (bufoff) + ldsw + _i * 8192), 16, 0, 0); } while (0)
#define PG8_LDA(dst, b, h) do { _Pragma("unroll") for (int m = 0; m < 4; ++m) _Pragma("unroll") for (int k = 0; k < 2; ++k) dst[m][k] = *(const LAS bf16x8*)(lds + PG8_SA(b, h) + aoff + m * 2048 + k * 1024); } while (0)
#define PG8_LDB(dst, b, h) do { _Pragma("unroll") for (int n = 0; n < 2; ++n) _Pragma("unroll") for (int k = 0; k < 2; ++k) dst[n][k] = *(const LAS bf16x8*)(lds + PG8_SB(b, h) + boff + n * 2048 + k * 1024); } while (0)
#define PG8_MMA(ai, bj, At, Bt) do { __builtin_amdgcn_s_setprio(1); _Pragma("unroll") for (int m = 0; m < 4; ++m) _Pragma("unroll") for (int n = 0; n < 2; ++n) _Pragma("unroll") for (int k = 0; k < 2; ++k) \
        acc[ai][bj][m][n] = __builtin_amdgcn_mfma_f32_16x16x32_bf16(Bt[n][k], At[m][k], acc[ai][bj][m][n], 0, 0, 0); __builtin_amdgcn_s_setprio(0); } while (0)
#define PG8_WAIT_V(n) asm volatile("s_waitcnt vmcnt(" #n ")" ::: "memory")
#define PG8_WAIT_L(n) asm volatile("s_waitcnt lgkmcnt(" #n ")" ::: "memory")
#define PG8_BAR __builtin_amdgcn_s_barrier()
#define PG8_SCHED __builtin_amdgcn_sched_barrier(0)
    Unit cur, nxt; int ui = 0;
    if (!S.next(0, cur)) return;
    f32x4 acc[2][2][4][2];
#pragma unroll
    for (int a = 0; a < 2; ++a)
#pragma unroll
        for (int b = 0; b < 2; ++b)
#pragma unroll
            for (int m = 0; m < 4; ++m)
#pragma unroll
                for (int n = 0; n < 2; ++n) acc[a][b][m][n] = (f32x4){0.f, 0.f, 0.f, 0.f};
    bf16x8 At[4][2], B0[2][2], B1[2][2];
    const char* cA = cur.a; const char* cB = cur.b;
    if constexpr (SP2) {
    PG8_STAGE(PG8_SB(0, 0), cB, voffB); PG8_STAGE(PG8_SB(0, 1), cB + hstepB, voffB); PG8_STAGE(PG8_SA(0, 0), cA, voffA); PG8_STAGE(PG8_SA(0, 1), cA + hstepA, voffA);
    if (wr == 1) PG8_BAR;
    PG8_WAIT_V(2); PG8_BAR;
    } else {
    PG8_STAGE(PG8_SB(0, 0), cB, voffB); PG8_STAGE(PG8_SA(0, 0), cA, voffA); PG8_STAGE(PG8_SB(0, 1), cB + hstepB, voffB); PG8_STAGE(PG8_SA(0, 1), cA + hstepA, voffA);
    if (wr == 1) PG8_BAR;
    PG8_WAIT_V(4); PG8_BAR;
    }
    PG8_STAGE(PG8_SB(1, 0), cB + kstep, voffB); PG8_STAGE(PG8_SA(1, 0), cA + kstep, voffA); PG8_STAGE(PG8_SB(1, 1), cB + hstepB + kstep, voffB);
    PG8_WAIT_V(6); PG8_BAR;
    for (;;) {
        const bool has_next = S.next(ui + 1, nxt);
        const char* nA = has_next ? nxt.a : cA; const char* nB = has_next ? nxt.b : cB;
        for (int t = 0; t < nt; t += 2) {
            const bool last = (t == nt - 2);
            const char* a1 = cA + (size_t)(t + 1) * kstep;
            const char* a2 = last ? nA : cA + (size_t)(t + 2) * kstep; const char* b2 = last ? nB : cB + (size_t)(t + 2) * kstep;
            const char* a3 = a2 + kstep; const char* b3 = b2 + kstep;
            if constexpr (SP2) {
            PG8_LDB(B0, 0, 0); PG8_LDB(B1, 0, 1); PG8_SCHED; PG8_LDA(At, 0, 0); PG8_STAGE(PG8_SA(1, 1), a1 + hstepA, voffA);
            PG8_WAIT_V(8); PG8_WAIT_L(0); PG8_BAR; PG8_MMA(0, 0, At, B0); PG8_MMA(0, 1, At, B1); PG8_BAR; PG8_SCHED;
            PG8_LDA(At, 0, 1); PG8_STAGE(PG8_SB(0, 0), b2, voffB); PG8_STAGE(PG8_SB(0, 1), b2 + hstepB, voffB); PG8_STAGE(PG8_SA(0, 0), a2, voffA);
            PG8_WAIT_V(8); PG8_WAIT_L(0); PG8_BAR; PG8_MMA(1, 0, At, B0); PG8_MMA(1, 1, At, B1); PG8_BAR; PG8_SCHED;
            PG8_LDB(B0, 1, 0); PG8_LDB(B1, 1, 1); PG8_SCHED; PG8_LDA(At, 1, 0); PG8_STAGE(PG8_SA(0, 1), a2 + hstepA, voffA);
            PG8_WAIT_V(8); PG8_WAIT_L(0); PG8_BAR; PG8_MMA(0, 0, At, B0); PG8_MMA(0, 1, At, B1); PG8_BAR; PG8_SCHED;
            PG8_LDA(At, 1, 1); PG8_STAGE(PG8_SB(1, 0), b3, voffB); PG8_STAGE(PG8_SB(1, 1), b3 + hstepB, voffB); PG8_STAGE(PG8_SA(1, 0), a3, voffA);
            PG8_WAIT_V(8); PG8_WAIT_L(0); PG8_BAR; PG8_MMA(1, 0, At, B0); PG8_MMA(1, 1, At, B1); PG8_BAR; PG8_SCHED;
            } else {
            PG8_LDB(B0, 0, 0); PG8_SCHED; PG8_LDA(At, 0, 0); PG8_STAGE(PG8_SA(1, 1), a1 + hstepA, voffA);
            PG8_WAIT_L(8); PG8_BAR; PG8_WAIT_L(0); PG8_MMA(0, 0, At, B0); PG8_BAR; PG8_SCHED;
            PG8_LDB(B1, 0, 1); PG8_STAGE(PG8_SB(0, 0), b2, voffB);
            PG8_BAR; PG8_WAIT_L(0); PG8_MMA(0, 1, At, B1); PG8_BAR;
            PG8_LDA(At, 0, 1); PG8_STAGE(PG8_SA(0, 0), a2, voffA);
            PG8_BAR; PG8_WAIT_L(0); PG8_MMA(1, 0, At, B0); PG8_BAR; PG8_SCHED;
            PG8_STAGE(PG8_SB(0, 1), b2 + hstepB, voffB);
            PG8_WAIT_V(6); PG8_BAR; PG8_MMA(1, 1, At, B1); PG8_BAR;
            PG8_LDB(B0, 1, 0); PG8_SCHED; PG8_LDA(At, 1, 0); PG8_STAGE(PG8_SA(0, 1), a2 + hstepA, voffA);
            PG8_WAIT_L(8); PG8_BAR; PG8_WAIT_L(0); PG8_MMA(0, 0, At, B0); PG8_BAR; PG8_SCHED;
            PG8_LDB(B1, 1, 1); PG8_STAGE(PG8_SB(1, 0), b3, voffB);
            PG8_BAR; PG8_WAIT_L(0); PG8_MMA(0, 1, At, B1); PG8_BAR;
            PG8_LDA(At, 1, 1); PG8_STAGE(PG8_SA(1, 0), a3, voffA);
            PG8_BAR; PG8_WAIT_L(0); PG8_MMA(1, 0, At, B0); PG8_BAR; PG8_SCHED;
            PG8_STAGE(PG8_SB(1, 1), b3 + hstepB, voffB);
            PG8_WAIT_V(6); PG8_BAR; PG8_MMA(1, 1, At, B1); PG8_BAR;
            }
        }
        if constexpr (ALIGN_EPI) { if (wr == 0) PG8_BAR; }
        bool zero_acc = true;
        if constexpr (Epi::CHAIN) zero_acc = E.chain(acc, cur, wr, wc, fr, fq); else E(acc, cur, wr, wc, fr, fq);
        if (!has_next) break;
        if (zero_acc)
#pragma unroll
        for (int a = 0; a < 2; ++a)
#pragma unroll
            for (int b = 0; b < 2; ++b)
#pragma unroll
                for (int m = 0; m < 4; ++m)
#pragma unroll
                    for (int n = 0; n < 2; ++n) acc[a][b][m][n] = (f32x4){0.f, 0.f, 0.f, 0.f};
        cur = nxt; cA = nA; cB = nB; ++ui;
        if constexpr (ALIGN_EPI) { if (wr == 1) PG8_BAR; }
    }
    PG8_WAIT_V(0);
    if constexpr (!ALIGN_EPI) { if (wr == 0) PG8_BAR; }
    PG8_BAR;
#undef PG8_SA
#undef PG8_SB
#undef PG8_STAGE
#undef PG8_LDA
#undef PG8_LDB
#undef PG8_MMA
#undef PG8_WAIT_V
#undef PG8_WAIT_L
#undef PG8_BAR
#undef PG8_SCHED
}

__device__ __forceinline__ u32x4 pack8(const f32x4& v0, const f32x4& v1) {
    u32x4 o; o[0] = cvtpk(v0[0], v0[1]); o[1] = cvtpk(v0[2], v0[3]); o[2] = cvtpk(v1[0], v1[1]); o[3] = cvtpk(v1[2], v1[3]); return o;
}

struct SchedIn {
    static constexpr int BHALF_ROWS = 128; static __device__ __forceinline__ int bmap(int R) { return R; }
    const char* H; const char* WN; const char* WT; int G, c;
    __device__ bool next(int i, Unit& u) const {
        const long L = (long)i * G + c;
        if (L < 2992) { tile_order(L, NTOK / 256, NNAT / 256, u.pm, u.pn); u.a = H + (size_t)u.pm * 256 * 2048; u.b = WN + (size_t)u.pn * 256 * 2048; u.aux = 0; return true; }
        if (!tile_order(L - 2992, NTR / 256, NTOK / 256, u.pm, u.pn)) return false;
        u.a = WT + (size_t)u.pm * 256 * 2048; u.b = H + (size_t)u.pn * 256 * 2048; u.aux = 1; return true;
    }
};
struct EpiIn {
    static constexpr bool PERM = true, CHAIN = false;
    unsigned char* ws;
    __device__ __forceinline__ void operator()(const f32x4 (&acc)[2][2][4][2], const Unit& u, int wr, int wc, int fr, int fq) const {
        size_t base; int ld, c0, r0; float scale = 1.f;
        if (u.aux == 0) { const int colt = u.pn * 256; r0 = u.pm * 256;
            if (colt < 512) { base = WS_AQ; ld = 512; c0 = colt; }
            else if (colt < 1024) { base = WS_AK; ld = 512; c0 = colt - 512; scale = 0.08838834764831845f; }
            else if (colt < 8192) { const int s = (colt - 1024) >> 10; ld = 1024; c0 = (colt - 1024) & 1023;
                base = s == 0 ? WS_AO : s == 1 ? WS_AZ : s == 2 ? WS_BQ : s == 3 ? WS_BK : s == 4 ? WS_BZ : s == 5 ? WS_CU : WS_CZ; }
            else { base = WS_MG; ld = 3072; c0 = colt - 8192; } }
        else { const int rt = u.pm * 256, tt0 = u.pn * 256, b = tt0 / TB, tb0 = tt0 - b * TB; ld = TB;
            if (rt < 1024) { base = WS_AVT; r0 = b * 1024 + rt; } else { base = WS_BVT; r0 = b * 1024 + rt - 1024; }
            c0 = tb0; }
        bf16_t* O = (bf16_t*)(ws + base);
        const int row0 = r0 + wr * 64 + fr, col0 = c0 + wc * 32 + 8 * fq;
#pragma unroll
        for (int ai = 0; ai < 2; ++ai)
#pragma unroll
            for (int m = 0; m < 4; ++m) { bf16_t* rowp = O + (size_t)(row0 + ai * 128 + m * 16) * ld + col0;
#pragma unroll
                for (int bj = 0; bj < 2; ++bj) *(u32x4*)(rowp + bj * 128) = pack8(acc[ai][bj][m][0] * scale, acc[ai][bj][m][1] * scale); }
    }
};
struct SchedF1L {
    static constexpr int BHALF_ROWS = 16; static __device__ __forceinline__ int bmap(int R) { return 64 * (R & 7) + (R >> 3); }
    const char* T2A; const char* CU; int G, c;
    __device__ bool next(int i, Unit& u) const {
        const long L = (long)i * G + c; if (L >= 4 * 2 * 64) return false;
        const int g = (int)(L >> 7), rem = (int)(L & 127); u.pm = rem >> 6; const int bt = rem & 63, b = bt >> 4, tl = bt & 15; u.pn = bt; u.aux = g;
        u.a = T2A + (size_t)u.pm * 256 * 512; u.b = CU + ((size_t)b * TB + 256 + 512 * (tl >> 1) + 32 * (tl & 1)) * 2048 + (size_t)g * 512; return true;
    }
};
struct EpiF1L {
    static constexpr bool PERM = true, CHAIN = false;
    unsigned char* ws;
    __device__ __forceinline__ void operator()(const f32x4 (&acc)[2][2][4][2], const Unit& u, int wr, int wc, int fr, int fq) const {
        const int part = u.pm, g = u.aux, b = u.pn >> 4, tl = u.pn & 15, a8 = 8 * (tl >> 1), n20 = 32 * (tl & 1);
        bf16_t* Z = (bf16_t*)(ws + WS_ZTL);
        const int row0 = wr * 64 + fr;
#pragma unroll
        for (int ai = 0; ai < 2; ++ai)
#pragma unroll
            for (int m = 0; m < 4; ++m) { const int ch = g * 256 + row0 + ai * 128 + m * 16;
#pragma unroll
                for (int bj = 0; bj < 2; ++bj) { const int n2 = n20 + 16 * bj + 4 * wc + fq;
                    *(u32x4*)(Z + ((size_t)(b * 1024 + ch) * 64 + n2) * 128 + part * 64 + a8) = pack8(acc[ai][bj][m][0], acc[ai][bj][m][1]); } }
    }
};
struct SchedF1C {
    static constexpr int BHALF_ROWS = 128; static __device__ __forceinline__ int bmap(int R) { return R; }
    const char* T2A; const char* CU; int G, c;
    __device__ bool next(int i, Unit& u) const {
        const long L = (long)i * G + c; if (L >= 4 * 2 * 4) return false;
        const int g = (int)(L >> 3), rem = (int)(L & 7); u.pm = rem >> 2; u.pn = rem & 3; u.aux = g;
        u.a = T2A + (size_t)u.pm * 256 * 512; u.b = CU + ((size_t)u.pn * TB) * 2048 + (size_t)g * 512; return true;
    }
};
struct EpiF1C {
    static constexpr bool PERM = true, CHAIN = false;
    unsigned char* ws;
    __device__ __forceinline__ void operator()(const f32x4 (&acc)[2][2][4][2], const Unit& u, int wr, int wc, int fr, int fq) const {
        const int part = u.pm, g = u.aux, b = u.pn;
        bf16_t* Z = (bf16_t*)(ws + WS_ZTC);
        const int row0 = wr * 64 + fr, col0 = wc * 32 + 8 * fq;
#pragma unroll
        for (int ai = 0; ai < 2; ++ai)
#pragma unroll
            for (int m = 0; m < 4; ++m) { const int ch = g * 256 + row0 + ai * 128 + m * 16;
                bf16_t* rowp = Z + ((size_t)(b * 1024 + ch) * 2 + part) * 256 + col0;
#pragma unroll
                for (int bj = 0; bj < 2; ++bj) *(u32x4*)(rowp + bj * 128) = pack8(acc[ai][bj][m][0], acc[ai][bj][m][1]); }
    }
};
struct SchedFA {
    static constexpr int BHALF_ROWS = 128; static __device__ __forceinline__ int bmap(int R) { return R; }
    const char* Zp; const char* F2T; int G, c;
    __device__ bool next(int i, Unit& u) const {
        const long L = (long)i * G + c; if (L >= 1024) return false;
        u.pm = (int)L; u.pn = 0; u.aux = 0; u.a = Zp + (size_t)L * 256 * 256; u.b = F2T; return true;
    }
};
struct EpiFA {
    static constexpr bool PERM = true, CHAIN = false;
    unsigned char* ws;
    __device__ __forceinline__ void operator()(const f32x4 (&acc)[2][2][4][2], const Unit& u, int wr, int wc, int fr, int fq) const {
        unsigned* Ap = (unsigned*)(ws + WS_T1);
        const int k10 = 16 * wc + 4 * fq;
#pragma unroll
        for (int ai = 0; ai < 2; ++ai)
#pragma unroll
            for (int m = 0; m < 4; ++m) { const int r = u.pm * 256 + ai * 128 + wr * 64 + m * 16 + fr, n2 = r & 63, ch = (r >> 6) & 1023, b = r >> 16;
#pragma unroll
                for (int q = 0; q < 4; ++q) { const int k1 = k10 + q; const f32x4 v = acc[ai][0][m][q >> 1];
                    const float ar = v[2 * (q & 1)], aim = v[2 * (q & 1) + 1];
                    const float rev = (float)(n2 * k1) * (1.f / 4096.f), cs = __builtin_amdgcn_cosf(rev), sn = __builtin_amdgcn_sinf(rev);
                    __hip_atomic_store(&Ap[((size_t)(b * 64 + k1) * 1024 + ch) * 64 + n2], cvtpk(ar * cs + aim * sn, aim * cs - ar * sn), __ATOMIC_RELAXED, __HIP_MEMORY_SCOPE_AGENT); } }
    }
};
struct SchedFB {
    static constexpr int BHALF_ROWS = 128; static __device__ __forceinline__ int bmap(int R) { return R; }
    const char* G2T; const char* Ap; int base;
    __device__ bool next(int i, Unit& u) const {
        if (i >= 4) return false; const long L = base + i;
        u.pm = 0; u.pn = (int)L; u.aux = 0; u.a = G2T; u.b = Ap + (size_t)L * 256 * 256; return true;
    }
};
struct EpiFB {
    static constexpr bool PERM = true, CHAIN = false;
    unsigned char* ws;
    __device__ __forceinline__ void operator()(const f32x4 (&acc)[2][2][4][2], const Unit& u, int wr, int wc, int fr, int fq) const {
        if (wr != 0) return;
        bf16_t* CZ = (bf16_t*)(ws + WS_CZ);
        const int R0 = u.pn * 256, b = R0 >> 16, k1 = (R0 >> 10) & 63, ch0 = (R0 & 1023) + wc * 32 + 8 * fq;
#pragma unroll
        for (int m = 0; m < 4; ++m) { const int k2 = 16 * m + fr;
            bf16_t* rowp = CZ + ((size_t)b * TB + 256 + k1 + 64 * k2) * 1024 + ch0;
#pragma unroll
            for (int bj = 0; bj < 2; ++bj) {
                const u32x4 z = *(const u32x4*)(rowp + bj * 128);
                f32x4 v0 = acc[0][bj][m][0] * (1.f / 1024.f), v1 = acc[0][bj][m][1] * (1.f / 1024.f);
                v0[0] *= silu(bf_lo(z[0])); v0[1] *= silu(bf_hi(z[0])); v0[2] *= silu(bf_lo(z[1])); v0[3] *= silu(bf_hi(z[1]));
                v1[0] *= silu(bf_lo(z[2])); v1[1] *= silu(bf_hi(z[2])); v1[2] *= silu(bf_lo(z[3])); v1[3] *= silu(bf_hi(z[3]));
                *(u32x4*)(rowp + bj * 128) = pack8(v0, v1); } }
    }
};
struct SchedOne {
    static constexpr int BHALF_ROWS = 128; static __device__ __forceinline__ int bmap(int R) { return R; }
    Unit u0;
    __device__ bool next(int i, Unit& u) const { if (i != 0) return false; u = u0; return true; }
};
struct EpiF2 {
    static constexpr bool PERM = true, CHAIN = false;
    unsigned char* ws; float scale;
    __device__ __forceinline__ void operator()(const f32x4 (&acc)[2][2][4][2], const Unit& u, int wr, int wc, int fr, int fq) const {
        bf16_t* CZ = (bf16_t*)(ws + WS_CZ);
        const int row0 = u.aux + wr * 64 + fr, col0 = u.pn * 256 + wc * 32 + 8 * fq;
#pragma unroll
        for (int ai = 0; ai < 2; ++ai)
#pragma unroll
            for (int m = 0; m < 4; ++m) { bf16_t* rowp = CZ + (size_t)(row0 + ai * 128 + m * 16) * 1024 + col0;
#pragma unroll
                for (int bj = 0; bj < 2; ++bj) {
                    const u32x4 z = *(const u32x4*)(rowp + bj * 128);
                    f32x4 v0 = acc[ai][bj][m][0] * scale, v1 = acc[ai][bj][m][1] * scale;
                    v0[0] *= silu(bf_lo(z[0])); v0[1] *= silu(bf_hi(z[0])); v0[2] *= silu(bf_lo(z[1])); v0[3] *= silu(bf_hi(z[1]));
                    v1[0] *= silu(bf_lo(z[2])); v1[1] *= silu(bf_hi(z[2])); v1[2] *= silu(bf_lo(z[3])); v1[3] *= silu(bf_hi(z[3]));
                    *(u32x4*)(rowp + bj * 128) = pack8(v0, v1); } }
    }
};
struct SchedM {
    static constexpr int BHALF_ROWS = 128; static __device__ __forceinline__ int bmap(int R) { return R; }
    const char* A; const char* W; int G, c; int skipctx;
    __device__ bool next(int i, Unit& u) const {
        if (!tile_order((long)i * G + c, skipctx ? 64 : 68, 4, u.pm, u.pn)) return false;
        if (skipctx) u.pm = (u.pm >> 4) * 17 + 1 + (u.pm & 15);
        u.a = A + (size_t)u.pm * 256 * 2048; u.b = W + (size_t)u.pn * 256 * 2048; u.aux = 0; return true;
    }
};
struct SchedM1C {
    static constexpr int BHALF_ROWS = 128; static __device__ __forceinline__ int bmap(int R) { return R; }
    const char* ws; int G, c; int skipctx;
    __device__ bool next(int i, Unit& u) const {
        const int un = i / 3, br = i - 3 * un;
        if (!tile_order((long)un * G + c, skipctx ? 64 : 68, 4, u.pm, u.pn)) return false;
        if (skipctx) u.pm = (u.pm >> 4) * 17 + 1 + (u.pm & 15);
        const size_t ybase = br == 0 ? WS_AO : (br == 1 ? WS_BZ : WS_CZ);
        u.a = ws + ybase + (size_t)u.pm * 256 * 2048; u.b = ws + WS_WOUT + (size_t)br * 2097152 + (size_t)u.pn * 256 * 2048; u.aux = br; return true;
    }
};
struct SchedM1Cq {
    static constexpr int BHALF_ROWS = 128; static __device__ __forceinline__ int bmap(int R) { return R; }
    const char* ws; int pm, pn;
    __device__ bool next(int i, Unit& u) const {
        if (i >= 3) return false; const int br = i; u.pm = pm; u.pn = pn;
        const size_t ybase = br == 0 ? WS_AO : (br == 1 ? WS_BZ : WS_CZ);
        u.a = ws + ybase + (size_t)pm * 256 * 2048; u.b = ws + WS_WOUT + (size_t)br * 2097152 + (size_t)pn * 256 * 2048; u.aux = br; return true;
    }
};
struct EpiM1C {
    static constexpr bool PERM = true, CHAIN = true;
    unsigned char* ws;
    __device__ __forceinline__ float epl(float g) const { return 1.f + __expf(-fminf(fmaxf(g, -30.f), 30.f)); }
    __device__ __forceinline__ bool chain(f32x4 (&acc)[2][2][4][2], const Unit& u, int wr, int wc, int fr, int fq) const {
        const bf16_t* MG = (const bf16_t*)(ws + WS_MG);
        bf16_t* YM = (bf16_t*)(ws + WS_H);
        const int br = u.aux;
        const int row0 = u.pm * 256 + wr * 64 + fr, col0 = u.pn * 256 + wc * 32 + 8 * fq;
#pragma unroll
        for (int ai = 0; ai < 2; ++ai)
#pragma unroll
            for (int m = 0; m < 4; ++m) { const size_t row = (size_t)(row0 + ai * 128 + m * 16);
#pragma unroll
                for (int bj = 0; bj < 2; ++bj) { const int col = col0 + bj * 128;
                    const u32x4 g = *(const u32x4*)(MG + row * 3072 + br * 1024 + col);
                    float f[8];
                    if (br < 2) { const u32x4 gn = *(const u32x4*)(MG + row * 3072 + (br + 1) * 1024 + col);
#pragma unroll
                        for (int q = 0; q < 4; ++q) { f[2 * q] = epl(bf_lo(gn[q])) * __builtin_amdgcn_rcpf(epl(bf_lo(g[q]))); f[2 * q + 1] = epl(bf_hi(gn[q])) * __builtin_amdgcn_rcpf(epl(bf_hi(g[q]))); } }
                    else {
#pragma unroll
                        for (int q = 0; q < 4; ++q) { f[2 * q] = __builtin_amdgcn_rcpf(epl(bf_lo(g[q]))); f[2 * q + 1] = __builtin_amdgcn_rcpf(epl(bf_hi(g[q]))); } }
                    f32x4 v0 = acc[ai][bj][m][0], v1 = acc[ai][bj][m][1];
                    v0[0] *= f[0]; v0[1] *= f[1]; v0[2] *= f[2]; v0[3] *= f[3]; v1[0] *= f[4]; v1[1] *= f[5]; v1[2] *= f[6]; v1[3] *= f[7];
                    if (br < 2) { acc[ai][bj][m][0] = v0; acc[ai][bj][m][1] = v1; }
                    else *(u32x4*)(YM + row * 1024 + col) = pack8(v0, v1); } }
        return br == 2;
    }
};
struct EpiM2 {
    static constexpr bool PERM = false, CHAIN = false;
    const float* xsrc; const float* csrc; float* xdst; float* cdst; const float* mod;
    __device__ __forceinline__ void operator()(const f32x4 (&acc)[2][2][4][2], const Unit& u, int wr, int wc, int fr, int fq) const {
        const int tt0 = u.pm * 256, b = tt0 / TB, tb0 = tt0 - b * TB;
        const bool isctx = tb0 < 256;
        const float* src = isctx ? csrc + (size_t)b * 256 * 1024 : xsrc + ((size_t)b * 4096 + (tb0 - 256)) * 1024;
        float* dst = isctx ? cdst + (size_t)b * 256 * 1024 : xdst + ((size_t)b * 4096 + (tb0 - 256)) * 1024;
        const float* gate = mod + (isctx ? 4 : b) * 3072 + 2048;
        const int row0 = wr * 64 + fr, col0 = u.pn * 256 + wc * 32 + 4 * fq;
        f32x4 gv[2][2];
#pragma unroll
        for (int bj = 0; bj < 2; ++bj)
#pragma unroll
            for (int n = 0; n < 2; ++n) gv[bj][n] = *(const f32x4*)(gate + col0 + bj * 128 + n * 16);
#pragma unroll
        for (int ai = 0; ai < 2; ++ai)
#pragma unroll
            for (int m = 0; m < 4; ++m) { const size_t ro = (size_t)(row0 + ai * 128 + m * 16) * 1024 + col0;
#pragma unroll
                for (int bj = 0; bj < 2; ++bj)
#pragma unroll
                    for (int n = 0; n < 2; ++n) { const size_t o = ro + bj * 128 + n * 16;
                        *(f32x4*)(dst + o) = *(const f32x4*)(src + o) + gv[bj][n] * acc[ai][bj][m][n]; } }
    }
};

__device__ __forceinline__ void convert_item(const Params& p, LAS unsigned char* lds, int l, int item) {
    const int tid = tid_opaque();
    const int kt = item & 15, nt = item >> 4;
    const float* src; size_t src_ld; int c0; bf16_t* dst;
    if (nt < 176) { const int n = nt * 64; c0 = n < 1024 ? n : (n < 5120 ? n + 1040 : n + 2064);
        src = p.in[7] + (size_t)l * DM * DIN; src_ld = DIN; dst = (bf16_t*)(p.ws + WS_WNAT) + (size_t)n * 1024; }
    else if (nt < 208) { const int n = (nt - 176) * 64; c0 = n < 1024 ? n + 1024 : n + 5136;
        src = p.in[7] + (size_t)l * DM * DIN; src_ld = DIN; dst = (bf16_t*)(p.ws + WS_WTR) + (size_t)n * 1024; }
    else { const int j = (nt - 208) >> 4, n = ((nt - 208) & 15) * 64; c0 = n;
        const float* w0 = p.in[17]; const float* w1 = p.in[18]; const float* w2 = p.in[19]; const float* w3 = p.in[20];
        asm volatile("" : "+s"(w0), "+s"(w1), "+s"(w2), "+s"(w3));
        src = (j == 0 ? w0 : j == 1 ? w1 : j == 2 ? w2 : w3) + (size_t)l * DM * DM; src_ld = DM; dst = (bf16_t*)(p.ws + WS_WOUT) + (size_t)j * DM * DM + (size_t)n * 1024; }
    LAS float* T = (LAS float*)(lds + 65536);
    const int k0 = kt * 64;
#pragma unroll
    for (int i = 0; i < 2; ++i) { const int idx = tid + 512 * i, kk = idx >> 4, c4 = (idx & 15) * 4;
        const f32x4 v = *(const f32x4*)(src + (size_t)(k0 + kk) * src_ld + c0 + c4);
        T[kk * 65 + c4] = v[0]; T[kk * 65 + c4 + 1] = v[1]; T[kk * 65 + c4 + 2] = v[2]; T[kk * 65 + c4 + 3] = v[3]; }
    __syncthreads();
    { const int n = tid >> 3, ks = (tid & 7) * 8;
      u32x4 o;
#pragma unroll
      for (int j = 0; j < 4; ++j) o[j] = cvtpk(T[(ks + 2 * j) * 65 + n], T[(ks + 2 * j + 1) * 65 + n]);
      *(u32x4*)(dst + (size_t)n * 1024 + k0 + ks) = o; }
    __syncthreads();
}
constexpr int N_CONV_ITEMS = 272 * 16;

__device__ __forceinline__ void phase0(const Params& p, LAS unsigned char* lds) {
    const int tid = tid_opaque(), G = gridDim.x, bid = blockIdx.x;
    LAS float* ctab = (LAS float*)lds;
    LAS float* sc = (LAS float*)(lds + 16384);
    LAS float* red = (LAS float*)(lds + 40960);
    for (int i = tid; i < 4096; i += 512) ctab[i] = cospif((float)i * (1.f / 2048.f));
    for (int i = tid; i < 5 * 1024; i += 512) { const float v = i < 4096 ? p.in[1][i] : p.in[3][i - 4096]; sc[i] = v / (1.f + expf(-v)); }
    __syncthreads();
    const int n_mod = 192, n_t1 = 2, n_t2 = 32;
    const int total = n_mod + n_t1 + n_t2 + N_CONV_ITEMS;
    for (int item = bid; item < total; item += G) {
        if (item < n_mod) {
            const int l = item / 48, j0 = (item % 48) * 64, col = tid & 63, kp = tid >> 6;
            const float* w = p.in[5] + ((size_t)l * 1024 + kp * 128) * 3072 + j0 + col;
            float a0 = 0.f, a1 = 0.f, a2 = 0.f, a3 = 0.f, a4 = 0.f;
#pragma unroll 8
            for (int k = 0; k < 128; ++k) { const float wv = w[(size_t)k * 3072]; const int kk = kp * 128 + k;
                a0 += sc[kk] * wv; a1 += sc[1024 + kk] * wv; a2 += sc[2048 + kk] * wv; a3 += sc[3072 + kk] * wv; a4 += sc[4096 + kk] * wv; }
            red[(kp * 5 + 0) * 64 + col] = a0; red[(kp * 5 + 1) * 64 + col] = a1; red[(kp * 5 + 2) * 64 + col] = a2; red[(kp * 5 + 3) * 64 + col] = a3; red[(kp * 5 + 4) * 64 + col] = a4;
            __syncthreads();
            if (tid < 320) { const int v = tid >> 6, c = tid & 63; float s = p.in[6][(size_t)l * 3072 + j0 + c];
#pragma unroll
                for (int q = 0; q < 8; ++q) s += red[(q * 5 + v) * 64 + c];
                ((float*)(p.ws + WS_MOD))[(size_t)(l * 5 + v) * 3072 + j0 + c] = s; }
            __syncthreads();
        } else if (item < n_mod + n_t1) {
            const int which = item - n_mod;
            bf16_t* T = (bf16_t*)(p.ws + (which == 0 ? WS_F2T : WS_G2T));
            for (int e = tid; e < 256 * 16; e += 512) { const int r = e >> 4, j0 = (e & 15) * 8; u32x4 o;
#pragma unroll
                for (int q = 0; q < 4; ++q) { float v[2];
#pragma unroll
                    for (int z = 0; z < 2; ++z) { const int j = j0 + 2 * q + z; float val = 0.f;
                        if (which == 0) { if (r < 128) { const int k1 = r >> 1, c = r & 1, part = j >> 6, n1 = j & 63, m = ((k1 * n1) & 63) * 64;
                                const int sh = (c == 0) ? (part == 0 ? 0 : 1024) : (part == 0 ? 1024 : 2048); val = ctab[(m + sh) & 4095]; } }
                        else { if (r < 64) { const int n2 = j >> 1, c = j & 1, m = ((r * n2) & 63) * 64; val = ctab[(m + (c == 0 ? 0 : 3072)) & 4095]; } }
                        v[z] = val; }
                    o[q] = cvtpk(v[0], v[1]); }
                *(u32x4*)(T + (size_t)r * 128 + j0) = o; }
        } else if (item < n_mod + n_t1 + n_t2) {
            const int it = item - n_mod - n_t1;
            if (it < 16) {
                bf16_t* T = (bf16_t*)(p.ws + WS_T2A);
                for (int e = tid; e < 32 * 32; e += 512) { const int r = it * 32 + (e >> 5), n0 = (e & 31) * 8; u32x4 o;
#pragma unroll
                    for (int q = 0; q < 4; ++q) { float v[2];
#pragma unroll
                        for (int z = 0; z < 2; ++z) { const int n = n0 + 2 * q + z; const int m = r < 256 ? ((r * n) & 255) * 16 : ((((r - 256) * n) & 255) * 16 - 1024) & 4095; v[z] = ctab[m]; }
                        o[q] = cvtpk(v[0], v[1]); }
                    *(u32x4*)(T + (size_t)r * 256 + n0) = o; }
            } else {
                bf16_t* T = (bf16_t*)(p.ws + WS_T2B);
                for (int e = tid; e < 16 * 64; e += 512) { const int r = (it - 16) * 16 + (e >> 6), j0 = (e & 63) * 8; u32x4 o;
#pragma unroll
                    for (int q = 0; q < 4; ++q) { float v[2];
#pragma unroll
                        for (int z = 0; z < 2; ++z) { const int j = j0 + 2 * q + z; const int m = j < 256 ? ((r * j) & 255) * 16 : ((((r * (j - 256)) & 255) * 16) + 1024) & 4095; v[z] = ctab[m]; }
                        o[q] = cvtpk(v[0], v[1]); }
                    *(u32x4*)(T + (size_t)r * 512 + j0) = o; }
            }
        } else {
            convert_item(p, lds, 0, item - n_mod - n_t1 - n_t2);
        }
    }
}

__device__ __forceinline__ void phase_prenorm(const Params& p, LAS unsigned char* lds, int l) {
    const int tid = tid_opaque(), lane = tid & 63, w = tid >> 6, G = gridDim.x, bid = blockIdx.x;
    LAS float* gw = (LAS float*)lds;
    { const float* wi = p.in[7] + (size_t)l * DM * DIN + 2048;
      for (int k = tid; k < 1024; k += 512) {
#pragma unroll
          for (int q = 0; q < 4; ++q) { const f32x4 v = *(const f32x4*)(wi + (size_t)k * DIN + 4 * q);
              gw[(4 * q + 0) * 1024 + k] = v[0]; gw[(4 * q + 1) * 1024 + k] = v[1]; gw[(4 * q + 2) * 1024 + k] = v[2]; gw[(4 * q + 3) * 1024 + k] = v[3]; } } }
    __syncthreads();
    const float* xsrc = l == 0 ? p.in[0] : p.out;
    const float* csrc = l == 0 ? p.in[2] : (const float*)(p.ws + WS_CTXS);
    const float* nw = p.in[4] + (size_t)l * 1024;
    const float* mod = (const float*)(p.ws + WS_MOD) + (size_t)l * 5 * 3072;
    bf16_t* H = (bf16_t*)(p.ws + WS_H);
    float* GT = (float*)(p.ws + WS_GATES);
    for (int r = bid * 8 + w; r < NTOK; r += G * 8) {
        const int b = r / TB, tb = r - b * TB;
        const float* xr = tb < 256 ? csrc + ((size_t)b * 256 + tb) * 1024 : xsrc + ((size_t)b * 4096 + tb - 256) * 1024;
        const float* md = mod + (tb < 256 ? 4 : b) * 3072;
        f32x4 x[4]; float ss = 0.f;
#pragma unroll
        for (int c = 0; c < 4; ++c) { x[c] = *(const f32x4*)(xr + c * 256 + lane * 4); ss += x[c][0] * x[c][0] + x[c][1] * x[c][1] + x[c][2] * x[c][2] + x[c][3] * x[c][3]; }
        ss = wave_sum(ss);
        const float rinv = rsqrtf(ss * (1.f / 1024.f) + EPS);
#pragma unroll
        for (int c = 0; c < 4; ++c) { const int k = c * 256 + lane * 4;
            const f32x4 wv = *(const f32x4*)(nw + k), sh = *(const f32x4*)(md + k), sca = *(const f32x4*)(md + 1024 + k);
#pragma unroll
            for (int e = 0; e < 4; ++e) x[c][e] = (x[c][e] * rinv) * wv[e] * (1.f + sca[e]) + sh[e];
            u32x2 o; o[0] = cvtpk(x[c][0], x[c][1]); o[1] = cvtpk(x[c][2], x[c][3]);
            *(u32x2*)(H + (size_t)r * 1024 + k) = o; }
        float mine = 0.f;
#pragma unroll
        for (int j = 0; j < 16; ++j) { float a = 0.f;
#pragma unroll
            for (int c = 0; c < 4; ++c) { const f32x4 g = *(const LAS f32x4*)(gw + j * 1024 + c * 256 + lane * 4);
                a += x[c][0] * g[0] + x[c][1] * g[1] + x[c][2] * g[2] + x[c][3] * g[3]; }
            a = wave_sum(a);
            if (lane == j) mine = a; }
        if (lane < 16) { float pre = mine + p.in[8][l * 16 + lane];
            const int ty = lane >> 2;
            if (ty & 1) pre = fminf(pre, 0.f) - __logf(1.f + __expf(-fabsf(pre)));
            GT[(size_t)r * 16 + lane] = pre; }
    }
    __syncthreads();
}

__device__ __forceinline__ void phase_qkprep(const Params& p, LAS unsigned char* lds, int l) {
    const int tid = tid_opaque(), lane = tid & 63, w = tid >> 6, G = gridDim.x, bid = blockIdx.x;
    LAS float* rc = (LAS float*)lds;
    LAS float* rs = (LAS float*)(lds + 4096);
    for (int i = tid; i < 1024; i += 512) { const int pos = i >> 4, j = i & 15;
        const float invf = powf(10000.f, -(float)(2 * j) / 32.f); float s, c; sincosf((float)pos * invf, &s, &c); rc[i] = c; rs[i] = s; }
    __syncthreads();
    const int qi = lane & 3;
    float wq[16], wk[16];
#pragma unroll
    for (int j = 0; j < 16; ++j) { wq[j] = p.in[10][l * 64 + qi * 16 + j]; wk[j] = p.in[11][l * 64 + qi * 16 + j]; }
    for (int r = bid * 8 + w; r < NTOK; r += G * 8) {
        const int b = r / TB, tb = r - b * TB;
        const bool lat = tb >= 256;
        const int pp = tb - 256, pos = (qi < 2) ? (pp >> 6) : (pp & 63);
#pragma unroll
        for (int which = 0; which < 2; ++which) {
            bf16_t* rowp = (bf16_t*)(p.ws + (which == 0 ? WS_BQ : WS_BK)) + (size_t)r * 1024 + lane * 16;
            const u32x4 u0 = *(const u32x4*)rowp, u1 = *(const u32x4*)(rowp + 8);
            float v[16];
#pragma unroll
            for (int q = 0; q < 4; ++q) { v[2 * q] = bf_lo(u0[q]); v[2 * q + 1] = bf_hi(u0[q]); v[8 + 2 * q] = bf_lo(u1[q]); v[8 + 2 * q + 1] = bf_hi(u1[q]); }
            float ss = 0.f;
#pragma unroll
            for (int j = 0; j < 16; ++j) ss += v[j] * v[j];
            ss += __shfl_xor(ss, 1); ss += __shfl_xor(ss, 2);
            const float rinv = rsqrtf(ss * (1.f / 64.f) + EPS);
#pragma unroll
            for (int j = 0; j < 16; ++j) v[j] = (v[j] * rinv) * (which == 0 ? wq[j] : wk[j]);
            if (lat) {
#pragma unroll
                for (int j = 0; j < 16; ++j) { const float other = __shfl_xor(v[j], 1); const float c = rc[pos * 16 + j], s = rs[pos * 16 + j];
                    v[j] = (qi & 1) ? (v[j] * c + other * s) : (v[j] * c - other * s); }
            }
            if (which == 0) {
#pragma unroll
                for (int j = 0; j < 16; ++j) v[j] *= 0.125f * LOG2E;
            }
            u32x4 o0, o1;
#pragma unroll
            for (int q = 0; q < 4; ++q) { o0[q] = cvtpk(v[2 * q], v[2 * q + 1]); o1[q] = cvtpk(v[8 + 2 * q], v[8 + 2 * q + 1]); }
            *(u32x4*)rowp = o0; *(u32x4*)(rowp + 8) = o1;
        }
    }
    __syncthreads();
}

__device__ __forceinline__ int swap23(int x) { return (x & ~12) | ((x & 4) << 1) | ((x & 8) >> 1); }
#define MFMA32(a, b, c) __builtin_amdgcn_mfma_f32_32x32x16_bf16((a), (b), (c), 0, 0, 0)
#define MFMA16(a, b, c) __builtin_amdgcn_mfma_f32_16x16x32_bf16((a), (b), (c), 0, 0, 0)

__device__ __forceinline__ int krow_perm(int k) { return (k & ~31) | (((k >> 2) & 1) << 4) | (((k >> 3) & 3) << 2) | (k & 3); }

template <bool SHIFT>
__device__ __forceinline__ void attn_body(const Params& p, LAS unsigned char* lds, int l, int b, int h, int q0, int nkt) {
    const int tid = tid_opaque(), w = tid >> 6, lane = tid & 63, fr = lane & 15, fg = lane >> 4, mp = w & 1, pr = w >> 1;
    constexpr int KSTR = 272, VSTR = 272, KBUF = 128 * KSTR, VBUF = 128 * VSTR;
    const float wqm = wave_max(fabsf(p.in[10][l * 64 + lane])), wkm = wave_max(fabsf(p.in[11][l * 64 + lane]));
    const float mb = 8.f * wqm * wkm * LOG2E;
    const float s1 = wave_sum(p.in[12][l * 64 + lane] * p.in[13][l * 64 + lane]), s2 = wave_sum(p.in[14][l * 64 + lane] * p.in[15][l * 64 + lane]);
    const float lam_init = 0.8f - 0.6f * expf(-0.3f * (float)l);
    const float lam = expf(s1) - expf(s2) + lam_init;
    const bf16_t* qbase = (const bf16_t*)(p.ws + WS_BQ) + ((size_t)(b * TB + q0 + 32 * pr + fr)) * 1024 + h * 128 + mp * 64;
    bf16x8 qf[2][2];
#pragma unroll
    for (int qg = 0; qg < 2; ++qg)
#pragma unroll
        for (int s = 0; s < 2; ++s) qf[qg][s] = *(const bf16x8*)(qbase + (size_t)(16 * qg) * 1024 + s * 32 + fg * 8);
    f32x4 O[2][8];
#pragma unroll
    for (int qg = 0; qg < 2; ++qg)
#pragma unroll
        for (int t = 0; t < 8; ++t) O[qg][t] = (f32x4){0.f, 0.f, 0.f, 0.f};
    float lsum[2] = {0.f, 0.f};
    const bf16_t* kg = (const bf16_t*)(p.ws + WS_BK) + ((size_t)b * TB) * 1024 + h * 128;
    const bf16_t* vg = (const bf16_t*)(p.ws + WS_BVT) + ((size_t)(b * 1024 + h * 128)) * TB;
    const int row0 = tid >> 4, cc = tid & 15;
    const bf16_t* kgp = kg + (size_t)row0 * 1024 + cc * 8;
    const bf16_t* vgp = vg + (size_t)row0 * TB + cc * 8;
    const unsigned klo = krow_perm(row0) * KSTR + cc * 16;
    const unsigned vlo = 2 * KBUF + row0 * VSTR + cc * 16;
    u32x4 sk[4], sv[4];
#pragma unroll
    for (int i = 0; i < 4; ++i) { sk[i] = *(const u32x4*)(kgp + (size_t)(32 * i) * 1024); sv[i] = *(const u32x4*)(vgp + (size_t)(32 * i) * TB); }
#pragma unroll
    for (int i = 0; i < 4; ++i) { *(LAS u32x4*)(lds + klo + 32 * i * KSTR) = sk[i]; *(LAS u32x4*)(lds + vlo + 32 * i * VSTR) = sv[i]; }
    __syncthreads();
    for (int t = 0; t < nkt; ++t) {
        const int cur = t & 1;
        const bool pf = (t + 1 < nkt);
        if (pf) { const size_t ko = (size_t)(t + 1) * 128;
#pragma unroll
            for (int i = 0; i < 4; ++i) { sk[i] = *(const u32x4*)(kgp + (ko + 32 * i) * 1024); sv[i] = *(const u32x4*)(vgp + (size_t)(32 * i) * TB + ko); } }
        const LAS unsigned char* Kb = lds + cur * KBUF + mp * 128;
        const LAS unsigned char* Vb = lds + 2 * KBUF + cur * VBUF;
#pragma unroll
        for (int hh = 0; hh < 2; ++hh) {
            bf16x8 pfr[2][2];
#pragma unroll
            for (int g2 = 0; g2 < 2; ++g2) {
                f32x4 S[2][2];
#pragma unroll
                for (int tt = 0; tt < 2; ++tt) { S[0][tt] = (f32x4){0.f, 0.f, 0.f, 0.f}; S[1][tt] = S[0][tt];
#pragma unroll
                    for (int s = 0; s < 2; ++s) { const bf16x8 kf = *(const LAS bf16x8*)(Kb + (64 * hh + 16 * (2 * g2 + tt) + fr) * KSTR + s * 64 + fg * 16);
                        S[0][tt] = MFMA16(kf, qf[0][s], S[0][tt]); S[1][tt] = MFMA16(kf, qf[1][s], S[1][tt]); } }
#pragma unroll
                for (int qg = 0; qg < 2; ++qg) { float ps = 0.f;
#pragma unroll
                    for (int tt = 0; tt < 2; ++tt)
#pragma unroll
                        for (int i = 0; i < 4; ++i) { S[qg][tt][i] = __builtin_amdgcn_exp2f(SHIFT ? S[qg][tt][i] - mb : S[qg][tt][i]); ps += S[qg][tt][i]; }
                    lsum[qg] += ps;
                    u32x4 wv; wv[0] = cvtpk_m(S[qg][0][0], S[qg][0][1]); wv[1] = cvtpk_m(S[qg][0][2], S[qg][0][3]); wv[2] = cvtpk_m(S[qg][1][0], S[qg][1][1]); wv[3] = cvtpk_m(S[qg][1][2], S[qg][1][3]);
                    pfr[qg][g2] = *reinterpret_cast<bf16x8*>(&wv); } }
#pragma unroll
            for (int D = 0; D < 8; ++D)
#pragma unroll
                for (int g2 = 0; g2 < 2; ++g2) { const bf16x8 vf = *(const LAS bf16x8*)(Vb + (16 * D + fr) * VSTR + (64 * hh + 32 * g2 + 8 * fg) * 2);
                    O[0][D] = MFMA16(vf, pfr[0][g2], O[0][D]); O[1][D] = MFMA16(vf, pfr[1][g2], O[1][D]); }
        }
        if (pf) { const unsigned o = (cur ^ 1);
#pragma unroll
            for (int i = 0; i < 4; ++i) { *(LAS u32x4*)(lds + o * KBUF + klo + 32 * i * KSTR) = sk[i]; *(LAS u32x4*)(lds + o * VBUF + vlo + 32 * i * VSTR) = sv[i]; } }
        __syncthreads();
    }
#pragma unroll
    for (int qg = 0; qg < 2; ++qg) { lsum[qg] += __shfl_xor(lsum[qg], 16); lsum[qg] += __shfl_xor(lsum[qg], 32); }
    const float cmy = mp == 0 ? 1.f : -lam;
    const float sc0 = cmy / lsum[0], sc1 = cmy / lsum[1];
    LAS f32x4* xch = (LAS f32x4*)lds;
#pragma unroll
    for (int D = 0; D < 8; ++D) { const f32x4 give = mp == 0 ? O[1][D] * sc1 : O[0][D] * sc0; xch[(w * 8 + D) * 64 + lane] = give; }
    __syncthreads();
    float ss = 0.f;
#pragma unroll
    for (int D = 0; D < 8; ++D) { const f32x4 got = xch[((w ^ 1) * 8 + D) * 64 + lane]; const f32x4 mine = mp == 0 ? O[0][D] * sc0 : O[1][D] * sc1;
        O[0][D] = mine + got;
#pragma unroll
        for (int i = 0; i < 4; ++i) ss += O[0][D][i] * O[0][D][i]; }
    ss += __shfl_xor(ss, 16); ss += __shfl_xor(ss, 32);
    const float rinv = rsqrtf(ss * (1.f / 128.f) + EPS) * (1.f - lam_init);
    bf16_t* bz = (bf16_t*)(p.ws + WS_BZ) + ((size_t)(b * TB + q0 + 32 * pr + 16 * mp + fr)) * 1024 + h * 128;
    const float* sw = p.in[16] + l * 128;
#pragma unroll
    for (int D = 0; D < 8; ++D) { const int dv = 16 * D + 4 * fg;
        const u32x2 z = *(const u32x2*)(bz + dv); const f32x4 wv = *(const f32x4*)(sw + dv);
        const float y0 = O[0][D][0] * rinv * wv[0] * silu(bf_lo(z[0])), y1 = O[0][D][1] * rinv * wv[1] * silu(bf_hi(z[0]));
        const float y2 = O[0][D][2] * rinv * wv[2] * silu(bf_lo(z[1])), y3 = O[0][D][3] * rinv * wv[3] * silu(bf_hi(z[1]));
        u32x2 o; o[0] = cvtpk(y0, y1); o[1] = cvtpk(y2, y3); *(u32x2*)(bz + dv) = o; }
    __syncthreads();
}
__device__ __forceinline__ void attn_item(const Params& p, LAS unsigned char* lds, int l, int b, int h, int q0, int nkt) {
    const int lane = tid_opaque() & 63;
    const float mbw = 8.f * wave_max(fabsf(p.in[10][l * 64 + lane])) * wave_max(fabsf(p.in[11][l * 64 + lane])) * LOG2E;
    if (__builtin_amdgcn_readfirstlane(mbw < 64.f ? 1 : 0)) attn_body<false>(p, lds, l, b, h, q0, nkt);
    else attn_body<true>(p, lds, l, b, h, q0, nkt);
}

__device__ __forceinline__ void mlstm_item(const Params& p, LAS unsigned char* lds, int item) {
    const int tid = tid_opaque(), w = tid >> 6, lane = tid & 63, fr = lane & 15, fg = lane >> 4;
    const int sl = item & 1, dir = (item >> 1) & 1, h = (item >> 2) & 3, b = item >> 4;
    constexpr int S272 = 272, S144 = 144;
    constexpr int OQ = 0, OK_ = 17408, OKT = 34816, OVT = 53248, OA = 71680, OCT = 80896, OVEC = 115712;
    LAS unsigned char* QS = lds + OQ; LAS unsigned char* KS = lds + OK_; LAS unsigned char* KT = lds + OKT;
    LAS unsigned char* VT = lds + OVT; LAS unsigned char* AS = lds + OA; LAS unsigned char* CT = lds + OCT;
    LAS float* ve = (LAS float*)(lds + OVEC);
    LAS float* vM = ve + 64;
    LAS float* vwi = ve + 128;
    LAS float* vwk = ve + 192;
    LAS float* vemr = ve + 256;
    LAS float* vden = ve + 320;
    LAS float* vn = ve + 384;
    LAS float* vsc = ve + 640;
    const bf16_t* AQ = (const bf16_t*)(p.ws + WS_AQ) + (size_t)b * TB * 512 + h * 128;
    const bf16_t* AK = (const bf16_t*)(p.ws + WS_AK) + (size_t)b * TB * 512 + h * 128;
    const bf16_t* AVT = (const bf16_t*)(p.ws + WS_AVT) + ((size_t)b * 1024 + h * 256 + sl * 128) * TB;
    const float* GT = (const float*)(p.ws + WS_GATES) + (size_t)b * TB * 16 + (dir * 2) * 4 + h;
    bf16_t* HO = (bf16_t*)(p.ws + (dir ? WS_HB : WS_HF)) + (size_t)b * TB * 1024 + h * 256 + sl * 128;
    for (int i = tid; i < 128 * S272 / 4; i += 512) ((LAS unsigned*)CT)[i] = 0u;
    if (tid < 256) vn[tid] = 0.f;
    f32x4 cst[8];
#pragma unroll
    for (int i = 0; i < 8; ++i) cst[i] = (f32x4){0.f, 0.f, 0.f, 0.f};
    float m_st = 0.f;
    const int qr0 = tid >> 4, qcc = tid & 15;
    const int tr0 = tid >> 3, tcc = tid & 7;
    auto chunk_tb0 = [&](int c) -> int { return dir == 0 ? 64 * c : (c < 4 ? 256 - 64 * (c + 1) : 4352 - 64 * (c - 3)); };
    u32x4 gq0, gq1, gk0, gk1, gv0, gv1; float gig = 0.f, glf = 0.f;
    auto issue = [&](int c) {
        const int tb0 = chunk_tb0(c);
        gq0 = *(const u32x4*)(AQ + (size_t)(tb0 + qr0) * 512 + qcc * 8); gq1 = *(const u32x4*)(AQ + (size_t)(tb0 + qr0 + 32) * 512 + qcc * 8);
        gk0 = *(const u32x4*)(AK + (size_t)(tb0 + qr0) * 512 + qcc * 8); gk1 = *(const u32x4*)(AK + (size_t)(tb0 + qr0 + 32) * 512 + qcc * 8);
        gv0 = *(const u32x4*)(AVT + (size_t)tr0 * TB + tb0 + tcc * 8); gv1 = *(const u32x4*)(AVT + (size_t)(tr0 + 64) * TB + tb0 + tcc * 8);
        if (w == 0) { gig = GT[(size_t)(tb0 + lane) * 16]; glf = GT[(size_t)(tb0 + lane) * 16 + 4]; }
    };
    auto commit = [&]() {
        *(LAS u32x4*)(QS + qr0 * S272 + qcc * 16) = gq0; *(LAS u32x4*)(QS + (qr0 + 32) * S272 + qcc * 16) = gq1;
        *(LAS u32x4*)(KS + qr0 * S272 + qcc * 16) = gk0; *(LAS u32x4*)(KS + (qr0 + 32) * S272 + qcc * 16) = gk1;
        *(LAS u32x4*)(VT + tr0 * S144 + tcc * 16) = gv0; *(LAS u32x4*)(VT + (tr0 + 64) * S144 + tcc * 16) = gv1;
    };
    issue(0); commit();
    float ig_c = gig, lf_c = glf;
    __syncthreads();
    for (int c = 0; c < 68; ++c) {
        const int tb0 = chunk_tb0(c);
        const int np = c & 1;
        if (c + 1 < 68) issue(c + 1);
        if (w == 0) {
            float bcum = lf_c, e;
            if (dir == 0) {
#pragma unroll
                for (int o = 1; o < 64; o <<= 1) { const float t = __shfl_up(bcum, o); if (lane >= o) bcum += t; }
            } else {
#pragma unroll
                for (int o = 1; o < 64; o <<= 1) { const float t = __shfl_down(bcum, o); if (lane + o < 64) bcum += t; }
            }
            e = ig_c - bcum;
            float cm = e;
            if (dir == 0) {
#pragma unroll
                for (int o = 1; o < 64; o <<= 1) { const float t = __shfl_up(cm, o); if (lane >= o) cm = fmaxf(cm, t); }
            } else {
#pragma unroll
                for (int o = 1; o < 64; o <<= 1) { const float t = __shfl_down(cm, o); if (lane + o < 64) cm = fmaxf(cm, t); }
            }
            const int lastl = dir == 0 ? 63 : 0;
            const float btot = __shfl(bcum, lastl), emax = __shfl(cm, lastl);
            const float Mv = fmaxf(cm, m_st);
            const float E = fmaxf(m_st, emax);
            ve[lane] = e; vM[lane] = Mv; vwi[lane] = __expf(m_st - Mv); vemr[lane] = __expf(-(bcum + Mv)); vwk[lane] = __expf(e - E);
            if (lane == 0) vsc[0] = __expf(m_st - E);
            m_st = btot + E;
            ig_c = gig; lf_c = glf;
        }
        f32x4 st[2];
        { const int sm = w >> 1, tn0 = 2 * (w & 1);
          st[0] = (f32x4){0.f, 0.f, 0.f, 0.f}; st[1] = st[0];
#pragma unroll
          for (int ks = 0; ks < 4; ++ks) { const bf16x8 af = *(const LAS bf16x8*)(KS + (16 * sm + fr) * S272 + ks * 64 + fg * 16);
#pragma unroll
              for (int j = 0; j < 2; ++j) { const bf16x8 bfr = *(const LAS bf16x8*)(QS + (16 * (tn0 + j) + fr) * S272 + ks * 64 + fg * 16); st[j] = MFMA16(af, bfr, st[j]); } } }
        __syncthreads();
        { const int sm = w >> 1, tn0 = 2 * (w & 1);
#pragma unroll
          for (int j = 0; j < 2; ++j) { const int t = 16 * (tn0 + j) + fr; const float Mt = vM[t]; float v[4];
#pragma unroll
              for (int i = 0; i < 4; ++i) { const int s = 16 * sm + 4 * fg + i; const bool ok = dir == 0 ? (s <= t) : (s >= t);
                  const float f = __expf(ve[s] - Mt); v[i] = ok ? st[j][i] * f : 0.f; }
              u32x2 o; o[0] = cvtpk(v[0], v[1]); o[1] = cvtpk(v[2], v[3]);
              *(LAS u32x2*)(AS + t * S144 + (16 * sm + 4 * fg) * 2) = o; } }
        { const int dk = tid >> 2, seg = tid & 3; LAS unsigned char* rowp = KT + dk * S144 + seg * 32;
          u32x4 a, bb; float sum = 0.f;
#pragma unroll
          for (int q = 0; q < 4; ++q) { const int s = seg * 16 + 2 * q;
              const float x0 = __uint_as_float((unsigned)(*(const LAS unsigned short*)(KS + s * S272 + dk * 2)) << 16) * vwk[s];
              const float x1 = __uint_as_float((unsigned)(*(const LAS unsigned short*)(KS + (s + 1) * S272 + dk * 2)) << 16) * vwk[s + 1];
              a[q] = cvtpk(x0, x1); sum += bf_lo(a[q]) + bf_hi(a[q]); }
#pragma unroll
          for (int q = 0; q < 4; ++q) { const int s = seg * 16 + 8 + 2 * q;
              const float x0 = __uint_as_float((unsigned)(*(const LAS unsigned short*)(KS + s * S272 + dk * 2)) << 16) * vwk[s];
              const float x1 = __uint_as_float((unsigned)(*(const LAS unsigned short*)(KS + (s + 1) * S272 + dk * 2)) << 16) * vwk[s + 1];
              bb[q] = cvtpk(x0, x1); sum += bf_lo(bb[q]) + bf_hi(bb[q]); }
          *(LAS u32x4*)rowp = a; *(LAS u32x4*)(rowp + 16) = bb;
          sum += __shfl_xor(sum, 1); sum += __shfl_xor(sum, 2);
          if (seg == 0) vn[(np ^ 1) * 128 + dk] = vsc[0] * vn[np * 128 + dk] + sum; }
        __syncthreads();
        { const int t = tid >> 3, part = tid & 7;
          const u32x4 a = *(const LAS u32x4*)(AS + t * S144 + part * 16);
          float ds = 0.f;
#pragma unroll
          for (int q = 0; q < 4; ++q) ds += bf_lo(a[q]) + bf_hi(a[q]);
          const u32x4 q0 = *(const LAS u32x4*)(QS + t * S272 + part * 32), q1 = *(const LAS u32x4*)(QS + t * S272 + part * 32 + 16);
          const LAS float* nn = vn + np * 128 + part * 16; float qn = 0.f;
#pragma unroll
          for (int q = 0; q < 4; ++q) { qn += bf_lo(q0[q]) * nn[2 * q] + bf_hi(q0[q]) * nn[2 * q + 1]; qn += bf_lo(q1[q]) * nn[8 + 2 * q] + bf_hi(q1[q]) * nn[8 + 2 * q + 1]; }
          ds += __shfl_xor(ds, 1); ds += __shfl_xor(ds, 2); ds += __shfl_xor(ds, 4);
          qn += __shfl_xor(qn, 1); qn += __shfl_xor(qn, 2); qn += __shfl_xor(qn, 4);
          if (part == 0) vden[t] = ds + vwi[t] * qn; }
        f32x4 n1[4], n2[4];
        {
#pragma unroll
          for (int j = 0; j < 4; ++j) { n1[j] = (f32x4){0.f, 0.f, 0.f, 0.f}; n2[j] = n1[j]; }
#pragma unroll
          for (int ks = 0; ks < 2; ++ks) { const bf16x8 af = *(const LAS bf16x8*)(VT + (16 * w + fr) * S144 + ks * 64 + fg * 16);
#pragma unroll
              for (int j = 0; j < 4; ++j) { const bf16x8 bfr = *(const LAS bf16x8*)(AS + (16 * j + fr) * S144 + ks * 64 + fg * 16); n1[j] = MFMA16(af, bfr, n1[j]); } }
#pragma unroll
          for (int ks = 0; ks < 4; ++ks) { const bf16x8 af = *(const LAS bf16x8*)(CT + (16 * w + fr) * S272 + ks * 64 + fg * 16);
#pragma unroll
              for (int j = 0; j < 4; ++j) { const bf16x8 bfr = *(const LAS bf16x8*)(QS + (16 * j + fr) * S272 + ks * 64 + fg * 16); n2[j] = MFMA16(af, bfr, n2[j]); } } }
        { const float decay = vsc[0];
#pragma unroll
          for (int dn = 0; dn < 8; ++dn) cst[dn] *= decay;
#pragma unroll
          for (int ks = 0; ks < 2; ++ks) { const bf16x8 af = *(const LAS bf16x8*)(KT + (16 * w + fr) * S144 + ks * 64 + fg * 16);
#pragma unroll
              for (int dn = 0; dn < 8; ++dn) { const bf16x8 bfr = *(const LAS bf16x8*)(VT + (16 * dn + fr) * S144 + ks * 64 + fg * 16); cst[dn] = MFMA16(af, bfr, cst[dn]); } } }
        __syncthreads();
        {
#pragma unroll
          for (int j = 0; j < 4; ++j) { const int t = 16 * j + fr; const float wi = vwi[t]; const float dinv = 1.f / fmaxf(fabsf(vden[t]), vemr[t]);
              const float h0 = (n1[j][0] + wi * n2[j][0]) * dinv, h1 = (n1[j][1] + wi * n2[j][1]) * dinv, h2 = (n1[j][2] + wi * n2[j][2]) * dinv, h3 = (n1[j][3] + wi * n2[j][3]) * dinv;
              u32x2 o; o[0] = cvtpk(h0, h1); o[1] = cvtpk(h2, h3);
              __hip_atomic_store((unsigned long long*)(HO + (size_t)(tb0 + t) * 1024 + 16 * w + 4 * fg), ((unsigned long long)o[1] << 32) | o[0], __ATOMIC_RELAXED, __HIP_MEMORY_SCOPE_AGENT); } }
#pragma unroll
        for (int dn = 0; dn < 8; ++dn) { u32x2 o; o[0] = cvtpk(cst[dn][0], cst[dn][1]); o[1] = cvtpk(cst[dn][2], cst[dn][3]);
            *(LAS u32x2*)(CT + (16 * dn + fr) * S272 + (16 * w + 4 * fg) * 2) = o; }
        if (c + 1 < 68) commit();
        __syncthreads();
    }
}

__device__ __forceinline__ void mlstm_out_rows(const Params& p, int l, int r0, int nrows) {
    const int tid = tid_opaque(), lane = tid & 63, w = tid >> 6;
    const float* anw = p.in[9] + (size_t)l * 1024 + lane * 16;
    float wv[16];
#pragma unroll
    for (int j = 0; j < 16; ++j) wv[j] = anw[j];
    for (int r = r0 + w; r < r0 + nrows; r += 8) {
        const size_t o = (size_t)r * 1024 + lane * 16;
        const bf16_t* hf = (const bf16_t*)(p.ws + WS_HF) + o; const bf16_t* hb = (const bf16_t*)(p.ws + WS_HB) + o;
        bf16_t* ao = (bf16_t*)(p.ws + WS_AO) + o; const bf16_t* az = (const bf16_t*)(p.ws + WS_AZ) + o;
        float v[16]; float ss = 0.f;
#pragma unroll
        for (int hh = 0; hh < 2; ++hh) { const u32x4 a = *(const u32x4*)(hf + 8 * hh), bb = *(const u32x4*)(hb + 8 * hh);
#pragma unroll
            for (int q = 0; q < 4; ++q) { v[8 * hh + 2 * q] = bf_lo(a[q]) + bf_lo(bb[q]); v[8 * hh + 2 * q + 1] = bf_hi(a[q]) + bf_hi(bb[q]); } }
#pragma unroll
        for (int j = 0; j < 16; ++j) ss += v[j] * v[j];
        ss += __shfl_xor(ss, 1); ss += __shfl_xor(ss, 2); ss += __shfl_xor(ss, 4); ss += __shfl_xor(ss, 8);
        const float rinv = rsqrtf(ss * (1.f / 256.f) + EPS);
#pragma unroll
        for (int hh = 0; hh < 2; ++hh) { const u32x4 a = *(const u32x4*)(ao + 8 * hh), z = *(const u32x4*)(az + 8 * hh); u32x4 oo;
#pragma unroll
            for (int q = 0; q < 4; ++q) { const int j = 8 * hh + 2 * q;
                const float y0 = (v[j] * rinv) * wv[j] * sigm(bf_lo(a[q])) * silu(bf_lo(z[q]));
                const float y1 = (v[j + 1] * rinv) * wv[j + 1] * sigm(bf_hi(a[q])) * silu(bf_hi(z[q]));
                oo[q] = cvtpk(y0, y1); }
            *(u32x4*)(ao + 8 * hh) = oo; }
    }
}

extern __shared__ __attribute__((aligned(16))) unsigned char dyn_lds[];

__global__ void __launch_bounds__(NTHREADS) mega_fwd(const Params p0) {
    typedef const Params __attribute__((address_space(4))) * KP;
    KP kp = (KP)__builtin_amdgcn_kernarg_segment_ptr();
#define P (*(const Params*)kp)
#define LAUNDER() do { KP _k = (KP)__builtin_amdgcn_kernarg_segment_ptr(); asm volatile("" : "+s"(_k)); kp = _k; } while (0)
    cg::grid_group grid = cg::this_grid();
    LAS unsigned char* lds = (LAS unsigned char*)dyn_lds;
    volatile LAS unsigned* st = (volatile LAS unsigned*)(lds + LDS_BYTES - 16);
    if (threadIdx.x == 0) { st[0] = 0u; st[1] = 0u; st[2] = 0u; st[3] = 0u; }
    __syncthreads();
    unsigned* ctl = (unsigned*)(P.ws + WS_CTL);
    XcdBarrier xb = xcd_barrier_post(ctl, st);
    const int G = gridDim.x, bid = blockIdx.x, tid = threadIdx.x;

    phase0(P, lds);
    grid.sync();

#pragma unroll 1
    for (int l = 0; l < DEPTH; ++l) {
        const bool last = (l == DEPTH - 1);
        LAUNDER();
        phase_prenorm(P, lds, l);
        LAUNDER();
        if (l > 0) { for (int item = bid; item < N_CONV_ITEMS; item += G) convert_item(P, lds, l, item); }
        xcd_barrier(xb);
        LAUNDER();
        { SchedIn S{(const char*)(P.ws + WS_H), (const char*)(P.ws + WS_WNAT), (const char*)(P.ws + WS_WTR), G, bid}; EpiIn E{P.ws};
          gemm_phase<true, true>(lds, 1024, 2048u, 2048u, S, E); }
        xcd_barrier(xb);
        LAUNDER();
        phase_qkprep(P, lds, l);
        LAUNDER();
        { SchedF1L S{(const char*)(P.ws + WS_T2A), (const char*)(P.ws + WS_CU), G, bid}; EpiF1L E{P.ws};
          gemm_phase(lds, 256, 512u, 2048u, S, E); }
        LAUNDER();
        { SchedF1C S{(const char*)(P.ws + WS_T2A), (const char*)(P.ws + WS_CU), G, G - 1 - bid}; EpiF1C E{P.ws};
          gemm_phase(lds, 256, 512u, 2048u, S, E); }
        xcd_barrier(xb);
        LAUNDER();
        {
            { SchedFA S{(const char*)(P.ws + WS_ZTL), (const char*)(P.ws + WS_F2T), G, bid}; EpiFA E{P.ws};
              gemm_phase<true, false>(lds, 128, 256u, 256u, S, E); }
            unsigned* cb = ctl + 12288 + 1024 * l;
            unsigned* fa_done = cb; unsigned* ml_done = cb + 64; unsigned* ctxf_done = cb + 128; unsigned* ctxa_done = cb + 192; unsigned* ctxo_done = cb + 256; unsigned* ctxm_done = cb + 320;
            publish_add_wt(fa_done);
            LAUNDER();
            unsigned* counter = ctl + 4096 + 64 * l;
            const int nc = last ? 0 : 1;
            const int e0 = 64, e1 = e0 + 16 * nc, e2 = e1 + 64 * nc, e3 = e2 + 640, e4 = e3 + 16 * nc, e5 = e4 + 16 * nc, e6 = e5 + 16 * nc, e7 = e6 + 384, e8 = e7 + 256, e9 = e8 + 256;
            for (;;) {
                __syncthreads();
                if (tid == 0) st[2] = atomicAdd(counter, 1u);
                __syncthreads();
                const int item = (int)st[2];
                LAUNDER();
                if (item >= e9) break;
                if (item < e0) { mlstm_item(P, lds, item); publish_add_wt(ml_done); continue; }
                if (item < e1) { const int it = item - e0, pn = it & 3, b = it >> 2;
                    SchedOne S; S.u0.pm = 0; S.u0.pn = pn; S.u0.aux = b * TB;
                    S.u0.a = (const char*)(P.ws + WS_T2B); S.u0.b = (const char*)(P.ws + WS_ZTC) + ((size_t)b * 1024 + pn * 256) * 1024;
                    EpiF2 E{P.ws, 1.f / 256.f};
                    gemm_phase(lds, 512, 1024u, 1024u, S, E); publish_add(ctxf_done); continue; }
                if (item < e2) { const int it = item - e1, qb = it & 1, h = (it >> 1) & 7, b = it >> 4; attn_item(P, lds, l, b, h, 128 * qb, 2); publish_add(ctxa_done); continue; }
                if (item < e3 || (item >= e6 && item < e7)) { const int it = item < e3 ? item - e2 : 640 + (item - e6); const int qb = it & 31, h = (it >> 5) & 7, b = it >> 8;
                    attn_item(P, lds, l, b, h, 256 + 128 * qb, 34); continue; }
                if (item < e4) { const int it = item - e3; wait_count(ml_done, 64u); mlstm_out_rows(P, l, (it >> 2) * TB + 64 * (it & 3), 64); publish_add(ctxo_done); continue; }
                if (item < e5) { const int it = item - e4, pn = it & 3, b = it >> 2;
                    wait_count(ctxf_done, 16u); wait_count(ctxa_done, 64u); wait_count(ctxo_done, 16u);
                    SchedM1Cq S{(const char*)P.ws, 17 * b, pn}; EpiM1C E{P.ws};
                    gemm_phase<true, true>(lds, 1024, 2048u, 2048u, S, E); publish_add(ctxm_done + 64 * b); continue; }
                if (item < e6) { const int it = item - e5, pn = it & 3, b = it >> 2;
                    wait_count(ctxm_done + 64 * b, 4u);
                    SchedOne S; S.u0.pm = 17 * b; S.u0.pn = pn; S.u0.aux = 0;
                    S.u0.a = (const char*)(P.ws + WS_H) + (size_t)(17 * b) * 256 * 2048; S.u0.b = (const char*)(P.ws + WS_WOUT + 3 * 2097152) + (size_t)pn * 256 * 2048;
                    EpiM2 E{l == 0 ? P.in[0] : P.out, l == 0 ? P.in[2] : (const float*)(P.ws + WS_CTXS), P.out, (float*)(P.ws + WS_CTXS), (const float*)(P.ws + WS_MOD) + (size_t)l * 5 * 3072};
                    gemm_phase(lds, 1024, 2048u, 2048u, S, E); continue; }
                if (item < e8) { const int it = item - e7;
                    wait_count(ml_done, 64u); mlstm_out_rows(P, l, (it >> 6) * TB + 256 + 64 * (it & 63), 64); continue; }
                { const int it = item - e8; wait_count(fa_done, (unsigned)G);
                  SchedFB S{(const char*)(P.ws + WS_G2T), (const char*)(P.ws + WS_T1), 4 * it}; EpiFB E{P.ws};
                  gemm_phase<true, false>(lds, 128, 256u, 256u, S, E); }
            }
        }
        xcd_barrier(xb);
        LAUNDER();
        { SchedM1C S{(const char*)P.ws, G, bid, 1}; EpiM1C E{P.ws}; gemm_phase<true, true>(lds, 1024, 2048u, 2048u, S, E); }
        xcd_barrier(xb);
        LAUNDER();
        { SchedM S{(const char*)(P.ws + WS_H), (const char*)(P.ws + WS_WOUT + 3 * 2097152), G, bid, 1};
          EpiM2 E{l == 0 ? P.in[0] : P.out, l == 0 ? P.in[2] : (const float*)(P.ws + WS_CTXS), P.out, (float*)(P.ws + WS_CTXS), (const float*)(P.ws + WS_MOD) + (size_t)l * 5 * 3072};
          gemm_phase(lds, 1024, 2048u, 2048u, S, E); }
        if (!last) xcd_barrier(xb);
    }
}

extern "C" void kernel_launch(void* const* d_in, const int* in_sizes, int n_in, void* d_out, int out_size,
                              void* d_ws, size_t ws_size, hipStream_t stream) {
    static int grid_blocks = 0;
    if (!grid_blocks) {
        int dev = 0, cus = 0, per_cu = 0;
        (void)hipGetDevice(&dev);
        (void)hipDeviceGetAttribute(&cus, hipDeviceAttributeMultiprocessorCount, dev);
        (void)hipFuncSetAttribute((const void*)mega_fwd, hipFuncAttributeMaxDynamicSharedMemorySize, LDS_BYTES);
        (void)hipOccupancyMaxActiveBlocksPerMultiprocessor(&per_cu, (const void*)mega_fwd, NTHREADS, LDS_BYTES);
        grid_blocks = cus;
        if (ws_size < WS_END || per_cu < 1) fprintf(stderr, "kernel_launch: ws %zu (need %zu), per_cu %d\n", ws_size, (size_t)WS_END, per_cu);
    }
    (void)hipMemsetAsync(d_ws, 0, 65536, stream);
    Params p{};
    for (int i = 0; i < 21 && i < n_in; ++i) p.in[i] = (const float*)d_in[i];
    p.out = (float*)d_out; p.ws = (unsigned char*)d_ws;
    void* args[] = {&p};
    hipError_t e = hipLaunchCooperativeKernel((const void*)mega_fwd, dim3(grid_blocks), dim3(NTHREADS), args, LDS_BYTES, stream);
    if (e != hipSuccess) fprintf(stderr, "cooperative launch failed: %s (grid %d)\n", hipGetErrorString(e), grid_blocks);
}
```

```cpp
#include <hip/hip_runtime.h>
#include <hip/hip_cooperative_groups.h>
#include <cstdio>
#include <cstdint>
namespace cg = cooperative_groups;

#define LAS __attribute__((address_space(3)))
typedef unsigned short bf16_t;
typedef short bf16x8 __attribute__((ext_vector_type(8)));
typedef float f32x4 __attribute__((ext_vector_type(4)));
typedef float f32x16 __attribute__((ext_vector_type(16)));
typedef unsigned u32x4 __attribute__((ext_vector_type(4)));
typedef unsigned u32x2 __attribute__((ext_vector_type(2)));

constexpr int NTHREADS = 512;
constexpr int LDS_BYTES = 144 * 1024;
constexpr int NB = 4, SEQ = 4096, CTXL = 256, TB = 4352, NTOK = NB * TB, DM = 1024, DIN = 13328, DEPTH = 4;
constexpr int NNAT = 11264, NTR = 2048;
constexpr float EPS = 1e-6f;
constexpr float LOG2E = 1.4426950408889634f;

constexpr size_t WS_CTL = 0;
constexpr size_t WS_MOD = 65536;
constexpr size_t WS_T2A = 311296;
constexpr size_t WS_T2B = 573440;
constexpr size_t WS_F2T = 835584;
constexpr size_t WS_G2T = 901120;
constexpr size_t WS_T1 = 1048576;
constexpr size_t WS_WNAT = 68157440;
constexpr size_t WS_WTR = 91226112;
constexpr size_t WS_WOUT = 96468992;
constexpr size_t WS_H = 104857600;
constexpr size_t WS_GATES = 140509184;
constexpr size_t WS_CTXS = 141623296;
constexpr size_t WS_AQ = 145817600;
constexpr size_t WS_AK = 163643392;
constexpr size_t WS_AKT = 181469184;
constexpr size_t WS_AVT = 199294976;
constexpr size_t WS_BVT = 234946560;
constexpr size_t WS_AO = 270598144;
constexpr size_t WS_AZ = 306249728;
constexpr size_t WS_BQ = 341901312;
constexpr size_t WS_BK = 377552896;
constexpr size_t WS_BZ = 413204480;
constexpr size_t WS_CU = 448856064;
constexpr size_t WS_CZ = 484507648;
constexpr size_t WS_MG = 520159232;
constexpr size_t WS_HF = 627113984;
constexpr size_t WS_HB = 662765568;
constexpr size_t WS_YMF = WS_HF;
constexpr size_t WS_ZTL = 698417152;
constexpr size_t WS_ZTC = 765526016;
constexpr size_t WS_END = 769720320;

#define XB_TMO      128
#define XB_XCNT(j)  (256  + 64 * (j))
#define XB_XSUB(j)  (1280 + 64 * (j))
#define XB_XGEN(j)  (2304 + 64 * (j))
#define XB_TOP      3328
#define XB_TOPGEN   3392
#define XCD_BAR_WORDS 3456
#define XB_SPIN_CAP (1u << 24)
__device__ __forceinline__ unsigned xb_ld(unsigned* p)              { return __hip_atomic_load(p, __ATOMIC_RELAXED, __HIP_MEMORY_SCOPE_AGENT); }
__device__ __forceinline__ unsigned xb_add(unsigned* p, unsigned v) { return __hip_atomic_fetch_add(p, v, __ATOMIC_RELAXED, __HIP_MEMORY_SCOPE_AGENT); }
__device__ __forceinline__ unsigned xb_xcc_id() { return (unsigned)__builtin_amdgcn_s_getreg((3 << 11) | 20) & 0xFu; }
#define XB_SPIN(cond, bar) do { unsigned _sp = 0; while (cond) { __builtin_amdgcn_s_sleep(1); \
    if ((++_sp & 255u) == 0u) { if (xb_ld(&(bar)[XB_TMO])) break; if (_sp > XB_SPIN_CAP) { atomicAdd(&(bar)[XB_TMO], 1u); break; } } } } while (0)
struct XcdBarrier { unsigned* bar; unsigned x; volatile LAS unsigned* st; };
__device__ __forceinline__ XcdBarrier xcd_barrier_post(unsigned* bar, volatile LAS unsigned* st) {
    XcdBarrier b; b.bar = bar; b.x = xb_xcc_id(); b.st = st;
    if (threadIdx.x == 0) (void)xb_add(&bar[XB_XCNT(b.x)], 1u);
    return b;
}
__device__ __forceinline__ void xcd_barrier_complete(unsigned* bar, unsigned x, unsigned& nloc, unsigned& nx) {
    const unsigned G = gridDim.x * gridDim.y * gridDim.z;
    unsigned sum, cnt, mine, sp = 0u;
    for (;;) {
        sum = 0u; cnt = 0u; mine = 0u;
#pragma unroll
        for (unsigned j = 0; j < 16; ++j) { const unsigned c = xb_ld(&bar[XB_XCNT(j)]); sum += c; cnt += (c > 0u) ? 1u : 0u; mine = (j == x) ? c : mine; }
        if (sum == G) break;
        __builtin_amdgcn_s_sleep(1);
        if ((++sp & 255u) == 0u) { if (xb_ld(&bar[XB_TMO])) break; if (sp > XB_SPIN_CAP) { atomicAdd(&bar[XB_TMO], 1u); break; } }
    }
    nloc = mine > 0u ? mine : 1u; nx = cnt > 0u ? cnt : 1u;
}
__device__ __forceinline__ void xcd_barrier(const XcdBarrier& b) {
    asm volatile("s_waitcnt vmcnt(0)" ::: "memory");
    __syncthreads();
    if (threadIdx.x == 0) {
        unsigned* bar = b.bar;
        __builtin_amdgcn_s_waitcnt(0);
        unsigned nloc = b.st[0], nx = b.st[1];
        if (nloc == 0u) { xcd_barrier_complete(bar, b.x, nloc, nx); b.st[0] = nloc; b.st[1] = nx; }
        const unsigned old = xb_add(&bar[XB_XSUB(b.x)], 1u);
        const unsigned gen = old / nloc;
        if (old + 1u == (gen + 1u) * nloc) {
            __builtin_amdgcn_fence(__ATOMIC_RELEASE, "agent");
            asm volatile("s_waitcnt vmcnt(0)" ::: "memory");
            const unsigned og = xb_add(&bar[XB_TOP], 1u);
            const unsigned tg = og / nx;
            if (og + 1u == (tg + 1u) * nx) xb_add(&bar[XB_TOPGEN], 1u);
            else XB_SPIN(xb_ld(&bar[XB_TOPGEN]) == tg, bar);
            __builtin_amdgcn_fence(__ATOMIC_ACQUIRE, "agent");
            xb_add(&bar[XB_XGEN(b.x)], 1u);
            asm volatile("s_waitcnt vmcnt(0)" ::: "memory");
        } else {
            XB_SPIN(xb_ld(&bar[XB_XGEN(b.x)]) == gen, bar);
            __builtin_amdgcn_fence(__ATOMIC_ACQUIRE, "agent");
            asm volatile("s_waitcnt vmcnt(0)" ::: "memory");
        }
    }
    __syncthreads();
}

__device__ __forceinline__ void publish_add(unsigned* ctr) {
    asm volatile("s_waitcnt vmcnt(0)" ::: "memory");
    __syncthreads();
    if (threadIdx.x == 0) { __builtin_amdgcn_fence(__ATOMIC_RELEASE, "agent"); asm volatile("s_waitcnt vmcnt(0)" ::: "memory"); (void)xb_add(ctr, 1u); }
}
__device__ __forceinline__ void publish_add_wt(unsigned* ctr) {
    asm volatile("s_waitcnt vmcnt(0)" ::: "memory");
    __syncthreads();
    if (threadIdx.x == 0) (void)xb_add(ctr, 1u);
}
__device__ __forceinline__ void wait_count(unsigned* ctr, unsigned need) {
    if (threadIdx.x == 0) { unsigned sp = 0; while (xb_ld(ctr) < need) { __builtin_amdgcn_s_sleep(2); if (++sp > (1u << 26)) break; }
        __builtin_amdgcn_fence(__ATOMIC_ACQUIRE, "agent"); asm volatile("s_waitcnt vmcnt(0)" ::: "memory"); }
    __syncthreads();
}

__device__ __forceinline__ unsigned cvtpk(float lo, float hi) { unsigned r; asm("s_nop 1\n\tv_cvt_pk_bf16_f32 %0, %1, %2" : "=v"(r) : "v"(lo), "v"(hi)); return r; }
__device__ __forceinline__ unsigned cvtpk_m(float lo, float hi) { unsigned r; asm("s_nop 1\n\tv_cvt_pk_bf16_f32 %0, %1, %2\n\ts_nop 1" : "=v"(r) : "v"(lo), "v"(hi)); return r; }
__device__ __forceinline__ float bf_lo(unsigned w) { return __uint_as_float(w << 16); }
__device__ __forceinline__ float bf_hi(unsigned w) { return __uint_as_float(w & 0xffff0000u); }
__device__ __forceinline__ float sigm(float x) { return 1.f / (1.f + __expf(-x)); }
__device__ __forceinline__ float silu(float x) { return x / (1.f + __expf(-x)); }
__device__ __forceinline__ float wave_sum(float v) {
#pragma unroll
    for (int o = 32; o > 0; o >>= 1) v += __shfl_xor(v, o);
    return v;
}
__device__ __forceinline__ float wave_max(float v) {
#pragma unroll
    for (int o = 32; o > 0; o >>= 1) v = fmaxf(v, __shfl_xor(v, o));
    return v;
}

__device__ __forceinline__ int tid_opaque() { int t = threadIdx.x; asm volatile("" : "+v"(t)); return t; }

struct Params {
    const float* in[21];
    float* out;
    unsigned char* ws;
};

constexpr int BM = 256, BK = 64, HALF = 128, HTB = HALF * BK * 2, STAGE_BYTES = 8 * HTB;
__device__ __forceinline__ int lds_byte(int r, int c) { const int st = (r >> 4) * 2 + (c >> 5), rr = r & 15, cc = c & 31, ob = rr * 64 + cc * 2; return st * 1024 + (ob ^ (((ob >> 9) & 1) << 5)); }
__device__ __forceinline__ void stage_rc(int b, int& R, int& C) { const int st = b / 1024, sb = b % 1024, swz = sb ^ (((sb >> 9) & 1) << 5); R = (st >> 1) * 16 + swz / 64; C = (st & 1) * 32 + (swz % 64) / 2; }
__device__ __forceinline__ int perm32(int rho) { const int n = rho >> 4, i = rho & 15; return 8 * (i >> 2) + 4 * n + (i & 3); }

struct Unit { int pm, pn, aux; const char* a; const char* b; };

__device__ __forceinline__ bool tile_order(long L, int nM, int nN, int& pm, int& pn) {
    const int nwg = nM * nN; if (L >= nwg) return false;
    int wgid = (int)L; { const int q = nwg / 8, r = nwg % 8, xcd = wgid % 8, off = wgid / 8; wgid = (xcd < r ? xcd * (q + 1) : r * (q + 1) + (xcd - r) * q) + off; }
    const int nig = 8 * nN, gid = wgid / nig, fm = gid * 8, gsz = (nM - fm) < 8 ? (nM - fm) : 8;
    pm = fm + ((wgid % nig) % gsz); pn = (wgid % nig) / gsz; return true;
}

template <bool ALIGN_EPI = false, bool SP2 = false, class Epi, class Sched>
__device__ __forceinline__ void gemm_phase(LAS unsigned char* lds, const int K, const unsigned lda, const unsigned ldb, const Sched& S, const Epi& E) {
    const int tid = tid_opaque(), wid = __builtin_amdgcn_readfirstlane(tid >> 6), lane = tid & 63, wr = wid >> 2, wc = wid & 3, fr = lane & 15, fq = lane >> 4;
    const int nt = K / BK;
    unsigned voffA[2], voffB[2];
#pragma unroll
    for (int i = 0; i < 2; ++i) { int R, C; stage_rc(tid * 16 + i * 8192, R, C); const int Rb = Epi::PERM ? ((R & ~31) + perm32(R & 31)) : R;
        voffA[i] = (unsigned)R * lda + (unsigned)C * 2u; voffB[i] = (unsigned)Sched::bmap(Rb) * ldb + (unsigned)C * 2u; }
    const size_t kstep = (size_t)(BK * 2);
    const size_t hstepA = (size_t)HALF * lda, hstepB = (size_t)Sched::BHALF_ROWS * ldb;
    const unsigned ldsw = (unsigned)wid * 1024u;
    const int aoff = lds_byte(wr * 64 + fr, fq * 8), boff = lds_byte(wc * 32 + fr, fq * 8);
#define PG8_SA(b, h) (((b) * 2 + (h)) * HTB)
#define PG8_SB(b, h) ((4 + (b) * 2 + (h)) * HTB)
#define PG8_STAGE(bufoff, gbase, voff) do { _Pragma("unroll") for (int _i = 0; _i < 2; ++_i) \
        __builtin_amdgcn_global_load_lds((const unsigned*)((const char*)(gbase) + (voff)[_i]), (LAS unsigned*)(lds + (bufoff) + ldsw + _i * 8192), 16, 0, 0); } while (0)
#define PG8_LDA(dst, b, h) do { _Pragma("unroll") for (int m = 0; m < 4; ++m) _Pragma("unroll") for (int k = 0; k < 2; ++k) dst[m][k] = *(const LAS bf16x8*)(lds + PG8_SA(b, h) + aoff + m * 2048 + k * 1024); } while (0)
#define PG8_LDB(dst, b, h) do { _Pragma("unroll") for (int n = 0; n < 2; ++n) _Pragma("unroll") for (int k = 0; k < 2; ++k) dst[n][k] = *(const LAS bf16x8*)(lds + PG8_SB(b, h) + boff + n * 2048 + k * 1024); } while (0)
#define PG8_MMA(ai, bj, At, Bt) do { __builtin_amdgcn_s_setprio(1); _Pragma("unroll") for (int m = 0; m < 4; ++m) _Pragma("unroll") for (int n = 0; n < 2; ++n) _Pragma("unroll") for (int k = 0; k < 2; ++k) \
        acc[ai][bj][m][n] = __builtin_amdgcn_mfma_f32_16x16x32_bf16(Bt[n][k], At[m][k], acc[ai][bj][m][n], 0, 0, 0); __builtin_amdgcn_s_setprio(0); } while (0)
#define PG8_WAIT_V(n) asm volatile("s_waitcnt vmcnt(" #n ")" ::: "memory")
#define PG8_WAIT_L(n) asm volatile("s_waitcnt lgkmcnt(" #n ")" ::: "memory")
#define PG8_BAR __builtin_amdgcn_s_barrier()
#define PG8_SCHED __builtin_amdgcn_sched_barrier(0)
    Unit cur, nxt; int ui = 0;
    if (!S.next(0, cur)) return;
    f32x4 acc[2][2][4][2];
#pragma unroll
    for (int a = 0; a < 2; ++a)
#pragma unroll
        for (int b = 0; b < 2; ++b)
#pragma unroll
            for (int m = 0; m < 4; ++m)
#pragma unroll
                for (int n = 0; n < 2; ++n) acc[a][b][m][n] = (f32x4){0.f, 0.f, 0.f, 0.f};
    bf16x8 At[4][2], B0[2][2], B1[2][2];
    const char* cA = cur.a; const char* cB = cur.b;
    if constexpr (SP2) {
    PG8_STAGE(PG8_SB(0, 0), cB, voffB); PG8_STAGE(PG8_SB(0, 1), cB + hstepB, voffB); PG8_STAGE(PG8_SA(0, 0), cA, voffA); PG8_STAGE(PG8_SA(0, 1), cA + hstepA, voffA);
    if (wr == 1) PG8_BAR;
    PG8_WAIT_V(2); PG8_BAR;
    } else {
    PG8_STAGE(PG8_SB(0, 0), cB, voffB); PG8_STAGE(PG8_SA(0, 0), cA, voffA); PG8_STAGE(PG8_SB(0, 1), cB + hstepB, voffB); PG8_STAGE(PG8_SA(0, 1), cA + hstepA, voffA);
    if (wr == 1) PG8_BAR;
    PG8_WAIT_V(4); PG8_BAR;
    }
    PG8_STAGE(PG8_SB(1, 0), cB + kstep, voffB); PG8_STAGE(PG8_SA(1, 0), cA + kstep, voffA); PG8_STAGE(PG8_SB(1, 1), cB + hstepB + kstep, voffB);
    PG8_WAIT_V(6); PG8_BAR;
    for (;;) {
        const bool has_next = S.next(ui + 1, nxt);
        const char* nA = has_next ? nxt.a : cA; const char* nB = has_next ? nxt.b : cB;
        for (int t = 0; t < nt; t += 2) {
            const bool last = (t == nt - 2);
            const char* a1 = cA + (size_t)(t + 1) * kstep;
            const char* a2 = last ? nA : cA + (size_t)(t + 2) * kstep; const char* b2 = last ? nB : cB + (size_t)(t + 2) * kstep;
            const char* a3 = a2 + kstep; const char* b3 = b2 + kstep;
            if constexpr (SP2) {
            PG8_LDB(B0, 0, 0); PG8_LDB(B1, 0, 1); PG8_SCHED; PG8_LDA(At, 0, 0); PG8_STAGE(PG8_SA(1, 1), a1 + hstepA, voffA);
            PG8_WAIT_V(8); PG8_WAIT_L(0); PG8_BAR; PG8_MMA(0, 0, At, B0); PG8_MMA(0, 1, At, B1); PG8_BAR; PG8_SCHED;
            PG8_LDA(At, 0, 1); PG8_STAGE(PG8_SB(0, 0), b2, voffB); PG8_STAGE(PG8_SB(0, 1), b2 + hstepB, voffB); PG8_STAGE(PG8_SA(0, 0), a2, voffA);
            PG8_WAIT_V(8); PG8_WAIT_L(0); PG8_BAR; PG8_MMA(1, 0, At, B0); PG8_MMA(1, 1, At, B1); PG8_BAR; PG8_SCHED;
            PG8_LDB(B0, 1, 0); PG8_LDB(B1, 1, 1); PG8_SCHED; PG8_LDA(At, 1, 0); PG8_STAGE(PG8_SA(0, 1), a2 + hstepA, voffA);
            PG8_WAIT_V(8); PG8_WAIT_L(0); PG8_BAR; PG8_MMA(0, 0, At, B0); PG8_MMA(0, 1, At, B1); PG8_BAR; PG8_SCHED;
            PG8_LDA(At, 1, 1); PG8_STAGE(PG8_SB(1, 0), b3, voffB); PG8_STAGE(PG8_SB(1, 1), b3 + hstepB, voffB); PG8_STAGE(PG8_SA(1, 0), a3, voffA);
            PG8_WAIT_V(8); PG8_WAIT_L(0); PG8_BAR; PG8_MMA(1, 0, At, B0); PG8_MMA(1, 1, At, B1); PG8_BAR; PG8_SCHED;
            } else {
            PG8_LDB(B0, 0, 0); PG8_SCHED; PG8_LDA(At, 0, 0); PG8_STAGE(PG8_SA(1, 1), a1 + hstepA, voffA);
            PG8_WAIT_L(8); PG8_BAR; PG8_WAIT_L(0); PG8_MMA(0, 0, At, B0); PG8_BAR; PG8_SCHED;
            PG8_LDB(B1, 0, 1); PG8_STAGE(PG8_SB(0, 0), b2, voffB);
            PG8_BAR; PG8_WAIT_L(0); PG8_MMA(0, 1, At, B1); PG8_BAR;
            PG8_LDA(At, 0, 1); PG8_STAGE(PG8_SA(0, 0), a2, voffA);
            PG8_BAR; PG8_WAIT_L(0); PG8_MMA(1, 0, At, B0); PG8_BAR; PG8_SCHED;
            PG8_STAGE(PG8_SB(0, 1), b2 + hstepB, voffB);
            PG8_WAIT_V(6); PG8_BAR; PG8_MMA(1, 1, At, B1); PG8_BAR;
            PG8_LDB(B0, 1, 0); PG8_SCHED; PG8_LDA(At, 1, 0); PG8_STAGE(PG8_SA(0, 1), a2 + hstepA, voffA);
            PG8_WAIT_L(8); PG8_BAR; PG8_WAIT_L(0); PG8_MMA(0, 0, At, B0); PG8_BAR; PG8_SCHED;
            PG8_LDB(B1, 1, 1); PG8_STAGE(PG8_SB(1, 0), b3, voffB);
            PG8_BAR; PG8_WAIT_L(0); PG8_MMA(0, 1, At, B1); PG8_BAR;
            PG8_LDA(At, 1, 1); PG8_STAGE(PG8_SA(1, 0), a3, voffA);
            PG8_BAR; PG8_WAIT_L(0); PG8_MMA(1, 0, At, B0); PG8_BAR; PG8_SCHED;
            PG8_STAGE(PG8_SB(1, 1), b3 + hstepB, voffB);
            PG8_WAIT_V(6); PG8_BAR; PG8_MMA(1, 1, At, B1); PG8_BAR;
            }
        }
        if constexpr (ALIGN_EPI) { if (wr == 0) PG8_BAR; }
        bool zero_acc = true;
        if constexpr (Epi::CHAIN) zero_acc = E.chain(acc, cur, wr, wc, fr, fq); else E(acc, cur, wr, wc, fr, fq);
        if (!has_next) break;
        if (zero_acc)
#pragma unroll
        for (int a = 0; a < 2; ++a)
#pragma unroll
            for (int b = 0; b < 2; ++b)
#pragma unroll
                for (int m = 0; m < 4; ++m)
#pragma unroll
                    for (int n = 0; n < 2; ++n) acc[a][b][m][n] = (f32x4){0.f, 0.f, 0.f, 0.f};
        cur = nxt; cA = nA; cB = nB; ++ui;
        if constexpr (ALIGN_EPI) { if (wr == 1) PG8_BAR; }
    }
    PG8_WAIT_V(0);
    if constexpr (!ALIGN_EPI) { if (wr == 0) PG8_BAR; }
    PG8_BAR;
#undef PG8_SA
#undef PG8_SB
#undef PG8_STAGE
#undef PG8_LDA
#undef PG8_LDB
#undef PG8_MMA
#undef PG8_WAIT_V
#undef PG8_WAIT_L
#undef PG8_BAR
#undef PG8_SCHED
}

__device__ __forceinline__ u32x4 pack8(const f32x4& v0, const f32x4& v1) {
    u32x4 o; o[0] = cvtpk(v0[0], v0[1]); o[1] = cvtpk(v0[2], v0[3]); o[2] = cvtpk(v1[0], v1[1]); o[3] = cvtpk(v1[2], v1[3]); return o;
}

struct SchedIn {
    static constexpr int BHALF_ROWS = 128; static __device__ __forceinline__ int bmap(int R) { return R; }
    const char* H; const char* WN; const char* WT; int G, c;
    __device__ bool next(int i, Unit& u) const {
        const long L = (long)i * G + c;
        if (L < 2992) { tile_order(L, NTOK / 256, NNAT / 256, u.pm, u.pn); u.a = H + (size_t)u.pm * 256 * 2048; u.b = WN + (size_t)u.pn * 256 * 2048; u.aux = 0; return true; }
        if (!tile_order(L - 2992, NTR / 256, NTOK / 256, u.pm, u.pn)) return false;
        u.a = WT + (size_t)u.pm * 256 * 2048; u.b = H + (size_t)u.pn * 256 * 2048; u.aux = 1; return true;
    }
};
struct EpiIn {
    static constexpr bool PERM = true, CHAIN = false;
    unsigned char* ws;
    __device__ __forceinline__ void operator()(const f32x4 (&acc)[2][2][4][2], const Unit& u, int wr, int wc, int fr, int fq) const {
        size_t base; int ld, c0, r0, act = 0; float scale = 1.f;
        if (u.aux == 0) { const int colt = u.pn * 256; r0 = u.pm * 256;
            if (colt < 512) { base = WS_AQ; ld = 512; c0 = colt; }
            else if (colt < 1024) { base = WS_AK; ld = 512; c0 = colt - 512; scale = 0.08838834764831845f; }
            else if (colt < 8192) { const int s = (colt - 1024) >> 10; ld = 1024; c0 = (colt - 1024) & 1023;
                base = s == 0 ? WS_AO : s == 1 ? WS_AZ : s == 2 ? WS_BQ : s == 3 ? WS_BK : s == 4 ? WS_BZ : s == 5 ? WS_CU : WS_CZ;
                act = s == 0 ? 1 : ((s == 1 || s == 4 || s == 6) ? 2 : 0); }
            else { base = WS_MG; ld = 3072; c0 = colt - 8192; } }
        else { const int rt = u.pm * 256, tt0 = u.pn * 256, b = tt0 / TB, tb0 = tt0 - b * TB; ld = TB;
            if (rt < 1024) { base = WS_AVT; r0 = b * 1024 + rt; } else { base = WS_BVT; r0 = b * 1024 + rt - 1024; }
            c0 = tb0; }
        bf16_t* O = (bf16_t*)(ws + base);
        const int row0 = r0 + wr * 64 + fr, col0 = c0 + wc * 32 + 8 * fq;
#pragma unroll
        for (int ai = 0; ai < 2; ++ai)
#pragma unroll
            for (int m = 0; m < 4; ++m) { bf16_t* rowp = O + (size_t)(row0 + ai * 128 + m * 16) * ld + col0;
#pragma unroll
                for (int bj = 0; bj < 2; ++bj) { f32x4 v0 = acc[ai][bj][m][0] * scale, v1 = acc[ai][bj][m][1] * scale;
                    if (act) {
#pragma unroll
                        for (int e = 0; e < 4; ++e) { const float s0 = __builtin_amdgcn_rcpf(1.f + __expf(-v0[e])), s1 = __builtin_amdgcn_rcpf(1.f + __expf(-v1[e]));
                            v0[e] = act == 1 ? s0 : v0[e] * s0; v1[e] = act == 1 ? s1 : v1[e] * s1; } }
                    *(u32x4*)(rowp + bj * 128) = pack8(v0, v1); } }
    }
};
struct SchedF1L {
    static constexpr int BHALF_ROWS = 16; static __device__ __forceinline__ int bmap(int R) { return 64 * (R & 7) + (R >> 3); }
    const char* T2A; const char* CU; int G, c;
    __device__ bool next(int i, Unit& u) const {
        const long L = (long)i * G + c; if (L >= 4 * 2 * 64) return false;
        const int g = (int)(L >> 7), rem = (int)(L & 127); u.pm = rem >> 6; const int bt = rem & 63, b = bt >> 4, tl = bt & 15; u.pn = bt; u.aux = g;
        u.a = T2A + (size_t)u.pm * 256 * 512; u.b = CU + ((size_t)b * TB + 256 + 512 * (tl >> 1) + 32 * (tl & 1)) * 2048 + (size_t)g * 512; return true;
    }
};
struct EpiF1L {
    static constexpr bool PERM = true, CHAIN = false;
    unsigned char* ws;
    __device__ __forceinline__ void operator()(const f32x4 (&acc)[2][2][4][2], const Unit& u, int wr, int wc, int fr, int fq) const {
        const int part = u.pm, g = u.aux, b = u.pn >> 4, tl = u.pn & 15, a8 = 8 * (tl >> 1), n20 = 32 * (tl & 1);
        bf16_t* Z = (bf16_t*)(ws + WS_ZTL);
        const int row0 = wr * 64 + fr;
#pragma unroll
        for (int ai = 0; ai < 2; ++ai)
#pragma unroll
            for (int m = 0; m < 4; ++m) { const int ch = g * 256 + row0 + ai * 128 + m * 16;
#pragma unroll
                for (int bj = 0; bj < 2; ++bj) { const int n2 = n20 + 16 * bj + 4 * wc + fq;
                    *(u32x4*)(Z + ((size_t)(b * 1024 + ch) * 64 + n2) * 128 + part * 64 + a8) = pack8(acc[ai][bj][m][0], acc[ai][bj][m][1]); } }
    }
};
struct SchedF1C {
    static constexpr int BHALF_ROWS = 128; static __device__ __forceinline__ int bmap(int R) { return R; }
    const char* T2A; const char* CU; int G, c;
    __device__ bool next(int i, Unit& u) const {
        const long L = (long)i * G + c; if (L >= 4 * 2 * 4) return false;
        const int g = (int)(L >> 3), rem = (int)(L & 7); u.pm = rem >> 2; u.pn = rem & 3; u.aux = g;
        u.a = T2A + (size_t)u.pm * 256 * 512; u.b = CU + ((size_t)u.pn * TB) * 2048 + (size_t)g * 512; return true;
    }
};
struct EpiF1C {
    static constexpr bool PERM = true, CHAIN = false;
    unsigned char* ws;
    __device__ __forceinline__ void operator()(const f32x4 (&acc)[2][2][4][2], const Unit& u, int wr, int wc, int fr, int fq) const {
        const int part = u.pm, g = u.aux, b = u.pn;
        bf16_t* Z = (bf16_t*)(ws + WS_ZTC);
        const int row0 = wr * 64 + fr, col0 = wc * 32 + 8 * fq;
#pragma unroll
        for (int ai = 0; ai < 2; ++ai)
#pragma unroll
            for (int m = 0; m < 4; ++m) { const int ch = g * 256 + row0 + ai * 128 + m * 16;
                bf16_t* rowp = Z + ((size_t)(b * 1024 + ch) * 2 + part) * 256 + col0;
#pragma unroll
                for (int bj = 0; bj < 2; ++bj) *(u32x4*)(rowp + bj * 128) = pack8(acc[ai][bj][m][0], acc[ai][bj][m][1]); }
    }
};
struct SchedFA {
    static constexpr int BHALF_ROWS = 128; static __device__ __forceinline__ int bmap(int R) { return R; }
    const char* Zp; const char* F2T; int G, c;
    __device__ bool next(int i, Unit& u) const {
        const long L = (long)i * G + c; if (L >= 1024) return false;
        u.pm = (int)L; u.pn = 0; u.aux = 0; u.a = Zp + (size_t)L * 256 * 256; u.b = F2T; return true;
    }
};
struct EpiFA {
    static constexpr bool PERM = true, CHAIN = false;
    unsigned char* ws;
    __device__ __forceinline__ void operator()(const f32x4 (&acc)[2][2][4][2], const Unit& u, int wr, int wc, int fr, int fq) const {
        unsigned* Ap = (unsigned*)(ws + WS_T1);
        const int k10 = 16 * wc + 4 * fq;
#pragma unroll
        for (int ai = 0; ai < 2; ++ai)
#pragma unroll
            for (int m = 0; m < 4; ++m) { const int r = u.pm * 256 + ai * 128 + wr * 64 + m * 16 + fr, n2 = r & 63, ch = (r >> 6) & 1023, b = r >> 16;
#pragma unroll
                for (int q = 0; q < 4; ++q) { const int k1 = k10 + q; const f32x4 v = acc[ai][0][m][q >> 1];
                    const float ar = v[2 * (q & 1)], aim = v[2 * (q & 1) + 1];
                    const float rev = (float)(n2 * k1) * (1.f / 4096.f), cs = __builtin_amdgcn_cosf(rev), sn = __builtin_amdgcn_sinf(rev);
                    __hip_atomic_store(&Ap[((size_t)(b * 64 + k1) * 1024 + ch) * 64 + n2], cvtpk(ar * cs + aim * sn, aim * cs - ar * sn), __ATOMIC_RELAXED, __HIP_MEMORY_SCOPE_AGENT); } }
    }
};
struct SchedFB {
    static constexpr int BHALF_ROWS = 128; static __device__ __forceinline__ int bmap(int R) { return R; }
    const char* G2T; const char* Ap; int base;
    __device__ bool next(int i, Unit& u) const {
        if (i >= 4) return false; const long L = base + i;
        u.pm = 0; u.pn = (int)L; u.aux = 0; u.a = G2T; u.b = Ap + (size_t)L * 256 * 256; return true;
    }
};
struct EpiFB {
    static constexpr bool PERM = true, CHAIN = false;
    unsigned char* ws;
    __device__ __forceinline__ void operator()(const f32x4 (&acc)[2][2][4][2], const Unit& u, int wr, int wc, int fr, int fq) const {
        if (wr != 0) return;
        bf16_t* CZ = (bf16_t*)(ws + WS_CZ);
        const int R0 = u.pn * 256, b = R0 >> 16, k1 = (R0 >> 10) & 63, ch0 = (R0 & 1023) + wc * 32 + 8 * fq;
#pragma unroll
        for (int m = 0; m < 4; ++m) { const int k2 = 16 * m + fr;
            bf16_t* rowp = CZ + ((size_t)b * TB + 256 + k1 + 64 * k2) * 1024 + ch0;
#pragma unroll
            for (int bj = 0; bj < 2; ++bj) {
                const u32x4 z = *(const u32x4*)(rowp + bj * 128);
                f32x4 v0 = acc[0][bj][m][0] * (1.f / 1024.f), v1 = acc[0][bj][m][1] * (1.f / 1024.f);
                v0[0] *= bf_lo(z[0]); v0[1] *= bf_hi(z[0]); v0[2] *= bf_lo(z[1]); v0[3] *= bf_hi(z[1]);
                v1[0] *= bf_lo(z[2]); v1[1] *= bf_hi(z[2]); v1[2] *= bf_lo(z[3]); v1[3] *= bf_hi(z[3]);
                *(u32x4*)(rowp + bj * 128) = pack8(v0, v1); } }
    }
};
struct SchedOne {
    static constexpr int BHALF_ROWS = 128; static __device__ __forceinline__ int bmap(int R) { return R; }
    Unit u0;
    __device__ bool next(int i, Unit& u) const { if (i != 0) return false; u = u0; return true; }
};
struct EpiF2 {
    static constexpr bool PERM = true, CHAIN = false;
    unsigned char* ws; float scale;
    __device__ __forceinline__ void operator()(const f32x4 (&acc)[2][2][4][2], const Unit& u, int wr, int wc, int fr, int fq) const {
        bf16_t* CZ = (bf16_t*)(ws + WS_CZ);
        const int row0 = u.aux + wr * 64 + fr, col0 = u.pn * 256 + wc * 32 + 8 * fq;
#pragma unroll
        for (int ai = 0; ai < 2; ++ai)
#pragma unroll
            for (int m = 0; m < 4; ++m) { bf16_t* rowp = CZ + (size_t)(row0 + ai * 128 + m * 16) * 1024 + col0;
#pragma unroll
                for (int bj = 0; bj < 2; ++bj) {
                    const u32x4 z = *(const u32x4*)(rowp + bj * 128);
                    f32x4 v0 = acc[ai][bj][m][0] * scale, v1 = acc[ai][bj][m][1] * scale;
                    v0[0] *= bf_lo(z[0]); v0[1] *= bf_hi(z[0]); v0[2] *= bf_lo(z[1]); v0[3] *= bf_hi(z[1]);
                    v1[0] *= bf_lo(z[2]); v1[1] *= bf_hi(z[2]); v1[2] *= bf_lo(z[3]); v1[3] *= bf_hi(z[3]);
                    *(u32x4*)(rowp + bj * 128) = pack8(v0, v1); } }
    }
};
struct SchedM {
    static constexpr int BHALF_ROWS = 128; static __device__ __forceinline__ int bmap(int R) { return R; }
    const char* A; const char* W; int G, c; int skipctx;
    __device__ bool next(int i, Unit& u) const {
        if (!tile_order((long)i * G + c, skipctx ? 64 : 68, 4, u.pm, u.pn)) return false;
        if (skipctx) u.pm = (u.pm >> 4) * 17 + 1 + (u.pm & 15);
        u.a = A + (size_t)u.pm * 256 * 2048; u.b = W + (size_t)u.pn * 256 * 2048; u.aux = 0; return true;
    }
};
struct SchedM1C {
    static constexpr int BHALF_ROWS = 128; static __device__ __forceinline__ int bmap(int R) { return R; }
    const char* ws; int G, c; int skipctx;
    __device__ bool next(int i, Unit& u) const {
        const int un = i / 3, br = i - 3 * un;
        if (!tile_order((long)un * G + c, skipctx ? 64 : 68, 4, u.pm, u.pn)) return false;
        if (skipctx) u.pm = (u.pm >> 4) * 17 + 1 + (u.pm & 15);
        const size_t ybase = br == 0 ? WS_AO : (br == 1 ? WS_BZ : WS_CZ);
        u.a = ws + ybase + (size_t)u.pm * 256 * 2048; u.b = ws + WS_WOUT + (size_t)br * 2097152 + (size_t)u.pn * 256 * 2048; u.aux = br; return true;
    }
};
struct SchedM1Cq {
    static constexpr int BHALF_ROWS = 128; static __device__ __forceinline__ int bmap(int R) { return R; }
    const char* ws; int pm, pn;
    __device__ bool next(int i, Unit& u) const {
        if (i >= 3) return false; const int br = i; u.pm = pm; u.pn = pn;
        const size_t ybase = br == 0 ? WS_AO : (br == 1 ? WS_BZ : WS_CZ);
        u.a = ws + ybase + (size_t)pm * 256 * 2048; u.b = ws + WS_WOUT + (size_t)br * 2097152 + (size_t)pn * 256 * 2048; u.aux = br; return true;
    }
};
struct EpiM1C {
    static constexpr bool PERM = true, CHAIN = true;
    unsigned char* ws;
    __device__ __forceinline__ float epl(float g) const { return 1.f + __expf(-fminf(fmaxf(g, -30.f), 30.f)); }
    __device__ __forceinline__ bool chain(f32x4 (&acc)[2][2][4][2], const Unit& u, int wr, int wc, int fr, int fq) const {
        const bf16_t* MG = (const bf16_t*)(ws + WS_MG);
        bf16_t* YM = (bf16_t*)(ws + WS_H);
        const int br = u.aux;
        const int row0 = u.pm * 256 + wr * 64 + fr, col0 = u.pn * 256 + wc * 32 + 8 * fq;
#pragma unroll
        for (int ai = 0; ai < 2; ++ai)
#pragma unroll
            for (int m = 0; m < 4; ++m) { const size_t row = (size_t)(row0 + ai * 128 + m * 16);
#pragma unroll
                for (int bj = 0; bj < 2; ++bj) { const int col = col0 + bj * 128;
                    const u32x4 g = *(const u32x4*)(MG + row * 3072 + br * 1024 + col);
                    float f[8];
                    if (br < 2) { const u32x4 gn = *(const u32x4*)(MG + row * 3072 + (br + 1) * 1024 + col);
#pragma unroll
                        for (int q = 0; q < 4; ++q) { f[2 * q] = epl(bf_lo(gn[q])) * __builtin_amdgcn_rcpf(epl(bf_lo(g[q]))); f[2 * q + 1] = epl(bf_hi(gn[q])) * __builtin_amdgcn_rcpf(epl(bf_hi(g[q]))); } }
                    else {
#pragma unroll
                        for (int q = 0; q < 4; ++q) { f[2 * q] = __builtin_amdgcn_rcpf(epl(bf_lo(g[q]))); f[2 * q + 1] = __builtin_amdgcn_rcpf(epl(bf_hi(g[q]))); } }
                    f32x4 v0 = acc[ai][bj][m][0], v1 = acc[ai][bj][m][1];
                    v0[0] *= f[0]; v0[1] *= f[1]; v0[2] *= f[2]; v0[3] *= f[3]; v1[0] *= f[4]; v1[1] *= f[5]; v1[2] *= f[6]; v1[3] *= f[7];
                    if (br < 2) { acc[ai][bj][m][0] = v0; acc[ai][bj][m][1] = v1; }
                    else *(u32x4*)(YM + row * 1024 + col) = pack8(v0, v1); } }
        return br == 2;
    }
};
struct EpiM2 {
    static constexpr bool PERM = false, CHAIN = false;
    const float* xsrc; const float* csrc; float* xdst; float* cdst; const float* mod;
    __device__ __forceinline__ void operator()(const f32x4 (&acc)[2][2][4][2], const Unit& u, int wr, int wc, int fr, int fq) const {
        const int tt0 = u.pm * 256, b = tt0 / TB, tb0 = tt0 - b * TB;
        const bool isctx = tb0 < 256;
        const float* src = isctx ? csrc + (size_t)b * 256 * 1024 : xsrc + ((size_t)b * 4096 + (tb0 - 256)) * 1024;
        float* dst = isctx ? cdst + (size_t)b * 256 * 1024 : xdst + ((size_t)b * 4096 + (tb0 - 256)) * 1024;
        const float* gate = mod + (isctx ? 4 : b) * 3072 + 2048;
        const int row0 = wr * 64 + fr, col0 = u.pn * 256 + wc * 32 + 4 * fq;
        f32x4 gv[2][2];
#pragma unroll
        for (int bj = 0; bj < 2; ++bj)
#pragma unroll
            for (int n = 0; n < 2; ++n) gv[bj][n] = *(const f32x4*)(gate + col0 + bj * 128 + n * 16);
#pragma unroll
        for (int ai = 0; ai < 2; ++ai)
#pragma unroll
            for (int m = 0; m < 4; ++m) { const size_t ro = (size_t)(row0 + ai * 128 + m * 16) * 1024 + col0;
#pragma unroll
                for (int bj = 0; bj < 2; ++bj)
#pragma unroll
                    for (int n = 0; n < 2; ++n) { const size_t o = ro + bj * 128 + n * 16;
                        *(f32x4*)(dst + o) = *(const f32x4*)(src + o) + gv[bj][n] * acc[ai][bj][m][n]; } }
    }
};

__device__ __forceinline__ void convert_item(const Params& p, LAS unsigned char* lds, int l, int item) {
    const int tid = tid_opaque();
    const int kt = item & 15, nt = item >> 4;
    const float* src; size_t src_ld; int c0; bf16_t* dst;
    if (nt < 176) { const int n = nt * 64; c0 = n < 1024 ? n : (n < 5120 ? n + 1040 : n + 2064);
        src = p.in[7] + (size_t)l * DM * DIN; src_ld = DIN; dst = (bf16_t*)(p.ws + WS_WNAT) + (size_t)n * 1024; }
    else if (nt < 208) { const int n = (nt - 176) * 64; c0 = n < 1024 ? n + 1024 : n + 5136;
        src = p.in[7] + (size_t)l * DM * DIN; src_ld = DIN; dst = (bf16_t*)(p.ws + WS_WTR) + (size_t)n * 1024; }
    else { const int j = (nt - 208) >> 4, n = ((nt - 208) & 15) * 64; c0 = n;
        const float* w0 = p.in[17]; const float* w1 = p.in[18]; const float* w2 = p.in[19]; const float* w3 = p.in[20];
        asm volatile("" : "+s"(w0), "+s"(w1), "+s"(w2), "+s"(w3));
        src = (j == 0 ? w0 : j == 1 ? w1 : j == 2 ? w2 : w3) + (size_t)l * DM * DM; src_ld = DM; dst = (bf16_t*)(p.ws + WS_WOUT) + (size_t)j * DM * DM + (size_t)n * 1024; }
    LAS float* T = (LAS float*)(lds + 65536);
    const int k0 = kt * 64;
#pragma unroll
    for (int i = 0; i < 2; ++i) { const int idx = tid + 512 * i, kk = idx >> 4, c4 = (idx & 15) * 4;
        const f32x4 v = *(const f32x4*)(src + (size_t)(k0 + kk) * src_ld + c0 + c4);
        T[kk * 65 + c4] = v[0]; T[kk * 65 + c4 + 1] = v[1]; T[kk * 65 + c4 + 2] = v[2]; T[kk * 65 + c4 + 3] = v[3]; }
    __syncthreads();
    { const int n = tid >> 3, ks = (tid & 7) * 8;
      u32x4 o;
#pragma unroll
      for (int j = 0; j < 4; ++j) o[j] = cvtpk(T[(ks + 2 * j) * 65 + n], T[(ks + 2 * j + 1) * 65 + n]);
      *(u32x4*)(dst + (size_t)n * 1024 + k0 + ks) = o; }
    __syncthreads();
}
constexpr int N_CONV_ITEMS = 272 * 16;

__device__ __forceinline__ void phase0(const Params& p, LAS unsigned char* lds) {
    const int tid = tid_opaque(), G = gridDim.x, bid = blockIdx.x;
    LAS float* ctab = (LAS float*)lds;
    LAS float* sc = (LAS float*)(lds + 16384);
    LAS float* red = (LAS float*)(lds + 40960);
    for (int i = tid; i < 4096; i += 512) ctab[i] = cospif((float)i * (1.f / 2048.f));
    for (int i = tid; i < 5 * 1024; i += 512) { const float v = i < 4096 ? p.in[1][i] : p.in[3][i - 4096]; sc[i] = v / (1.f + expf(-v)); }
    __syncthreads();
    const int n_mod = 192, n_t1 = 2, n_t2 = 32;
    const int total = n_mod + n_t1 + n_t2 + N_CONV_ITEMS;
    for (int item = bid; item < total; item += G) {
        if (item < n_mod) {
            const int l = item / 48, j0 = (item % 48) * 64, col = tid & 63, kp = tid >> 6;
            const float* w = p.in[5] + ((size_t)l * 1024 + kp * 128) * 3072 + j0 + col;
            float a0 = 0.f, a1 = 0.f, a2 = 0.f, a3 = 0.f, a4 = 0.f;
#pragma unroll 8
            for (int k = 0; k < 128; ++k) { const float wv = w[(size_t)k * 3072]; const int kk = kp * 128 + k;
                a0 += sc[kk] * wv; a1 += sc[1024 + kk] * wv; a2 += sc[2048 + kk] * wv; a3 += sc[3072 + kk] * wv; a4 += sc[4096 + kk] * wv; }
            red[(kp * 5 + 0) * 64 + col] = a0; red[(kp * 5 + 1) * 64 + col] = a1; red[(kp * 5 + 2) * 64 + col] = a2; red[(kp * 5 + 3) * 64 + col] = a3; red[(kp * 5 + 4) * 64 + col] = a4;
            __syncthreads();
            if (tid < 320) { const int v = tid >> 6, c = tid & 63; float s = p.in[6][(size_t)l * 3072 + j0 + c];
#pragma unroll
                for (int q = 0; q < 8; ++q) s += red[(q * 5 + v) * 64 + c];
                ((float*)(p.ws + WS_MOD))[(size_t)(l * 5 + v) * 3072 + j0 + c] = s; }
            __syncthreads();
        } else if (item < n_mod + n_t1) {
            const int which = item - n_mod;
            bf16_t* T = (bf16_t*)(p.ws + (which == 0 ? WS_F2T : WS_G2T));
            for (int e = tid; e < 256 * 16; e += 512) { const int r = e >> 4, j0 = (e & 15) * 8; u32x4 o;
#pragma unroll
                for (int q = 0; q < 4; ++q) { float v[2];
#pragma unroll
                    for (int z = 0; z < 2; ++z) { const int j = j0 + 2 * q + z; float val = 0.f;
                        if (which == 0) { if (r < 128) { const int k1 = r >> 1, c = r & 1, part = j >> 6, n1 = j & 63, m = ((k1 * n1) & 63) * 64;
                                const int sh = (c == 0) ? (part == 0 ? 0 : 1024) : (part == 0 ? 1024 : 2048); val = ctab[(m + sh) & 4095]; } }
                        else { if (r < 64) { const int n2 = j >> 1, c = j & 1, m = ((r * n2) & 63) * 64; val = ctab[(m + (c == 0 ? 0 : 3072)) & 4095]; } }
                        v[z] = val; }
                    o[q] = cvtpk(v[0], v[1]); }
                *(u32x4*)(T + (size_t)r * 128 + j0) = o; }
        } else if (item < n_mod + n_t1 + n_t2) {
            const int it = item - n_mod - n_t1;
            if (it < 16) {
                bf16_t* T = (bf16_t*)(p.ws + WS_T2A);
                for (int e = tid; e < 32 * 32; e += 512) { const int r = it * 32 + (e >> 5), n0 = (e & 31) * 8; u32x4 o;
#pragma unroll
                    for (int q = 0; q < 4; ++q) { float v[2];
#pragma unroll
                        for (int z = 0; z < 2; ++z) { const int n = n0 + 2 * q + z; const int m = r < 256 ? ((r * n) & 255) * 16 : ((((r - 256) * n) & 255) * 16 - 1024) & 4095; v[z] = ctab[m]; }
                        o[q] = cvtpk(v[0], v[1]); }
                    *(u32x4*)(T + (size_t)r * 256 + n0) = o; }
            } else {
                bf16_t* T = (bf16_t*)(p.ws + WS_T2B);
                for (int e = tid; e < 16 * 64; e += 512) { const int r = (it - 16) * 16 + (e >> 6), j0 = (e & 63) * 8; u32x4 o;
#pragma unroll
                    for (int q = 0; q < 4; ++q) { float v[2];
#pragma unroll
                        for (int z = 0; z < 2; ++z) { const int j = j0 + 2 * q + z; const int m = j < 256 ? ((r * j) & 255) * 16 : ((((r * (j - 256)) & 255) * 16) + 1024) & 4095; v[z] = ctab[m]; }
                        o[q] = cvtpk(v[0], v[1]); }
                    *(u32x4*)(T + (size_t)r * 512 + j0) = o; }
            }
        } else {
            convert_item(p, lds, 0, item - n_mod - n_t1 - n_t2);
        }
    }
}

__device__ __forceinline__ void phase_prenorm(const Params& p, LAS unsigned char* lds, int l) {
    const int tid = tid_opaque(), lane = tid & 63, w = tid >> 6, G = gridDim.x, bid = blockIdx.x;
    LAS float* gw = (LAS float*)lds;
    { const float* wi = p.in[7] + (size_t)l * DM * DIN + 2048;
      for (int k = tid; k < 1024; k += 512) {
#pragma unroll
          for (int q = 0; q < 4; ++q) { const f32x4 v = *(const f32x4*)(wi + (size_t)k * DIN + 4 * q);
              gw[(4 * q + 0) * 1024 + k] = v[0]; gw[(4 * q + 1) * 1024 + k] = v[1]; gw[(4 * q + 2) * 1024 + k] = v[2]; gw[(4 * q + 3) * 1024 + k] = v[3]; } } }
    __syncthreads();
    const float* xsrc = l == 0 ? p.in[0] : p.out;
    const float* csrc = l == 0 ? p.in[2] : (const float*)(p.ws + WS_CTXS);
    const float* nw = p.in[4] + (size_t)l * 1024;
    const float* mod = (const float*)(p.ws + WS_MOD) + (size_t)l * 5 * 3072;
    bf16_t* H = (bf16_t*)(p.ws + WS_H);
    float* GT = (float*)(p.ws + WS_GATES);
    for (int r = bid * 8 + w; r < NTOK; r += G * 8) {
        const int b = r / TB, tb = r - b * TB;
        const float* xr = tb < 256 ? csrc + ((size_t)b * 256 + tb) * 1024 : xsrc + ((size_t)b * 4096 + tb - 256) * 1024;
        const float* md = mod + (tb < 256 ? 4 : b) * 3072;
        f32x4 x[4]; float ss = 0.f;
#pragma unroll
        for (int c = 0; c < 4; ++c) { x[c] = *(const f32x4*)(xr + c * 256 + lane * 4); ss += x[c][0] * x[c][0] + x[c][1] * x[c][1] + x[c][2] * x[c][2] + x[c][3] * x[c][3]; }
        ss = wave_sum(ss);
        const float rinv = rsqrtf(ss * (1.f / 1024.f) + EPS);
#pragma unroll
        for (int c = 0; c < 4; ++c) { const int k = c * 256 + lane * 4;
            const f32x4 wv = *(const f32x4*)(nw + k), sh = *(const f32x4*)(md + k), sca = *(const f32x4*)(md + 1024 + k);
#pragma unroll
            for (int e = 0; e < 4; ++e) x[c][e] = (x[c][e] * rinv) * wv[e] * (1.f + sca[e]) + sh[e];
            u32x2 o; o[0] = cvtpk(x[c][0], x[c][1]); o[1] = cvtpk(x[c][2], x[c][3]);
            *(u32x2*)(H + (size_t)r * 1024 + k) = o; }
        float mine = 0.f;
#pragma unroll
        for (int j = 0; j < 16; ++j) { float a = 0.f;
#pragma unroll
            for (int c = 0; c < 4; ++c) { const f32x4 g = *(const LAS f32x4*)(gw + j * 1024 + c * 256 + lane * 4);
                a += x[c][0] * g[0] + x[c][1] * g[1] + x[c][2] * g[2] + x[c][3] * g[3]; }
            a = wave_sum(a);
            if (lane == j) mine = a; }
        if (lane < 16) { float pre = mine + p.in[8][l * 16 + lane];
            const int ty = lane >> 2;
            if (ty & 1) pre = fminf(pre, 0.f) - __logf(1.f + __expf(-fabsf(pre)));
            GT[(size_t)r * 16 + lane] = pre; }
    }
    __syncthreads();
}

__device__ __forceinline__ void phase_qkprep(const Params& p, LAS unsigned char* lds, int l) {
    const int tid = tid_opaque(), lane = tid & 63, w = tid >> 6, G = gridDim.x, bid = blockIdx.x;
    LAS float* rc = (LAS float*)lds;
    LAS float* rs = (LAS float*)(lds + 4096);
    for (int i = tid; i < 1024; i += 512) { const int pos = i >> 4, j = i & 15;
        const float invf = powf(10000.f, -(float)(2 * j) / 32.f); float s, c; sincosf((float)pos * invf, &s, &c); rc[i] = c; rs[i] = s; }
    __syncthreads();
    const int qi = lane & 3;
    float wq[16], wk[16];
#pragma unroll
    for (int j = 0; j < 16; ++j) { wq[j] = p.in[10][l * 64 + qi * 16 + j]; wk[j] = p.in[11][l * 64 + qi * 16 + j]; }
    for (int r = bid * 8 + w; r < NTOK; r += G * 8) {
        const int b = r / TB, tb = r - b * TB;
        const bool lat = tb >= 256;
        const int pp = tb - 256, pos = (qi < 2) ? (pp >> 6) : (pp & 63);
#pragma unroll
        for (int which = 0; which < 2; ++which) {
            bf16_t* rowp = (bf16_t*)(p.ws + (which == 0 ? WS_BQ : WS_BK)) + (size_t)r * 1024 + lane * 16;
            const u32x4 u0 = *(const u32x4*)rowp, u1 = *(const u32x4*)(rowp + 8);
            float v[16];
#pragma unroll
            for (int q = 0; q < 4; ++q) { v[2 * q] = bf_lo(u0[q]); v[2 * q + 1] = bf_hi(u0[q]); v[8 + 2 * q] = bf_lo(u1[q]); v[8 + 2 * q + 1] = bf_hi(u1[q]); }
            float ss = 0.f;
#pragma unroll
            for (int j = 0; j < 16; ++j) ss += v[j] * v[j];
            ss += __shfl_xor(ss, 1); ss += __shfl_xor(ss, 2);
            const float rinv = rsqrtf(ss * (1.f / 64.f) + EPS);
#pragma unroll
            for (int j = 0; j < 16; ++j) v[j] = (v[j] * rinv) * (which == 0 ? wq[j] : wk[j]);
            if (lat) {
#pragma unroll
                for (int j = 0; j < 16; ++j) { const float other = __shfl_xor(v[j], 1); const float c = rc[pos * 16 + j], s = rs[pos * 16 + j];
                    v[j] = (qi & 1) ? (v[j] * c + other * s) : (v[j] * c - other * s); }
            }
            if (which == 0) {
#pragma unroll
                for (int j = 0; j < 16; ++j) v[j] *= 0.125f * LOG2E;
            }
            u32x4 o0, o1;
#pragma unroll
            for (int q = 0; q < 4; ++q) { o0[q] = cvtpk(v[2 * q], v[2 * q + 1]); o1[q] = cvtpk(v[8 + 2 * q], v[8 + 2 * q + 1]); }
            *(u32x4*)rowp = o0; *(u32x4*)(rowp + 8) = o1;
        }
    }
    __syncthreads();
}

__device__ __forceinline__ int swap23(int x) { return (x & ~12) | ((x & 4) << 1) | ((x & 8) >> 1); }
#define MFMA32(a, b, c) __builtin_amdgcn_mfma_f32_32x32x16_bf16((a), (b), (c), 0, 0, 0)
#define MFMA16(a, b, c) __builtin_amdgcn_mfma_f32_16x16x32_bf16((a), (b), (c), 0, 0, 0)

__device__ __forceinline__ int krow_perm(int k) { return (k & ~31) | (((k >> 2) & 1) << 4) | (((k >> 3) & 3) << 2) | (k & 3); }

template <bool SHIFT>
__device__ __forceinline__ void attn_body(const Params& p, LAS unsigned char* lds, int l, int b, int h, int q0, int nkt) {
    const int tid = tid_opaque(), w = tid >> 6, lane = tid & 63, fr = lane & 15, fg = lane >> 4, mp = w & 1, pr = w >> 1;
    constexpr int KSTR = 272, VSTR = 272, KBUF = 128 * KSTR, VBUF = 128 * VSTR;
    const float wqm = wave_max(fabsf(p.in[10][l * 64 + lane])), wkm = wave_max(fabsf(p.in[11][l * 64 + lane]));
    const float mb = 8.f * wqm * wkm * LOG2E;
    const float s1 = wave_sum(p.in[12][l * 64 + lane] * p.in[13][l * 64 + lane]), s2 = wave_sum(p.in[14][l * 64 + lane] * p.in[15][l * 64 + lane]);
    const float lam_init = 0.8f - 0.6f * expf(-0.3f * (float)l);
    const float lam = expf(s1) - expf(s2) + lam_init;
    const bf16_t* qbase = (const bf16_t*)(p.ws + WS_BQ) + ((size_t)(b * TB + q0 + 32 * pr + fr)) * 1024 + h * 128 + mp * 64;
    bf16x8 qf[2][2];
#pragma unroll
    for (int qg = 0; qg < 2; ++qg)
#pragma unroll
        for (int s = 0; s < 2; ++s) qf[qg][s] = *(const bf16x8*)(qbase + (size_t)(16 * qg) * 1024 + s * 32 + fg * 8);
    f32x4 O[2][8];
#pragma unroll
    for (int qg = 0; qg < 2; ++qg)
#pragma unroll
        for (int t = 0; t < 8; ++t) O[qg][t] = (f32x4){0.f, 0.f, 0.f, 0.f};
    float lsum[2] = {0.f, 0.f};
    const bf16_t* kg = (const bf16_t*)(p.ws + WS_BK) + ((size_t)b * TB) * 1024 + h * 128;
    const bf16_t* vg = (const bf16_t*)(p.ws + WS_BVT) + ((size_t)(b * 1024 + h * 128)) * TB;
    const int row0 = tid >> 4, cc = tid & 15;
    const bf16_t* kgp = kg + (size_t)row0 * 1024 + cc * 8;
    const bf16_t* vgp = vg + (size_t)row0 * TB + cc * 8;
    const unsigned klo = krow_perm(row0) * KSTR + cc * 16;
    const unsigned vlo = 2 * KBUF + row0 * VSTR + cc * 16;
    u32x4 sk[4], sv[4];
#pragma unroll
    for (int i = 0; i < 4; ++i) { sk[i] = *(const u32x4*)(kgp + (size_t)(32 * i) * 1024); sv[i] = *(const u32x4*)(vgp + (size_t)(32 * i) * TB); }
#pragma unroll
    for (int i = 0; i < 4; ++i) { *(LAS u32x4*)(lds + klo + 32 * i * KSTR) = sk[i]; *(LAS u32x4*)(lds + vlo + 32 * i * VSTR) = sv[i]; }
    __syncthreads();
    for (int t = 0; t < nkt; ++t) {
        const int cur = t & 1;
        const bool pf = (t + 1 < nkt);
        if (pf) { const size_t ko = (size_t)(t + 1) * 128;
#pragma unroll
            for (int i = 0; i < 4; ++i) { sk[i] = *(const u32x4*)(kgp + (ko + 32 * i) * 1024); sv[i] = *(const u32x4*)(vgp + (size_t)(32 * i) * TB + ko); } }
        const LAS unsigned char* Kb = lds + cur * KBUF + mp * 128;
        const LAS unsigned char* Vb = lds + 2 * KBUF + cur * VBUF;
#pragma unroll
        for (int hh = 0; hh < 2; ++hh) {
            bf16x8 pfr[2][2];
#pragma unroll
            for (int g2 = 0; g2 < 2; ++g2) {
                f32x4 S[2][2];
#pragma unroll
                for (int tt = 0; tt < 2; ++tt) { S[0][tt] = (f32x4){0.f, 0.f, 0.f, 0.f}; S[1][tt] = S[0][tt];
#pragma unroll
                    for (int s = 0; s < 2; ++s) { const bf16x8 kf = *(const LAS bf16x8*)(Kb + (64 * hh + 16 * (2 * g2 + tt) + fr) * KSTR + s * 64 + fg * 16);
                        S[0][tt] = MFMA16(kf, qf[0][s], S[0][tt]); S[1][tt] = MFMA16(kf, qf[1][s], S[1][tt]); } }
#pragma unroll
                for (int qg = 0; qg < 2; ++qg) { float ps = 0.f;
#pragma unroll
                    for (int tt = 0; tt < 2; ++tt)
#pragma unroll
                        for (int i = 0; i < 4; ++i) { S[qg][tt][i] = __builtin_amdgcn_exp2f(SHIFT ? S[qg][tt][i] - mb : S[qg][tt][i]); ps += S[qg][tt][i]; }
                    lsum[qg] += ps;
                    u32x4 wv; wv[0] = cvtpk_m(S[qg][0][0], S[qg][0][1]); wv[1] = cvtpk_m(S[qg][0][2], S[qg][0][3]); wv[2] = cvtpk_m(S[qg][1][0], S[qg][1][1]); wv[3] = cvtpk_m(S[qg][1][2], S[qg][1][3]);
                    pfr[qg][g2] = *reinterpret_cast<bf16x8*>(&wv); } }
#pragma unroll
            for (int D = 0; D < 8; ++D)
#pragma unroll
                for (int g2 = 0; g2 < 2; ++g2) { const bf16x8 vf = *(const LAS bf16x8*)(Vb + (16 * D + fr) * VSTR + (64 * hh + 32 * g2 + 8 * fg) * 2);
                    O[0][D] = MFMA16(vf, pfr[0][g2], O[0][D]); O[1][D] = MFMA16(vf, pfr[1][g2], O[1][D]); }
        }
        if (pf) { const unsigned o = (cur ^ 1);
#pragma unroll
            for (int i = 0; i < 4; ++i) { *(LAS u32x4*)(lds + o * KBUF + klo + 32 * i * KSTR) = sk[i]; *(LAS u32x4*)(lds + o * VBUF + vlo + 32 * i * VSTR) = sv[i]; } }
        __syncthreads();
    }
#pragma unroll
    for (int qg = 0; qg < 2; ++qg) { lsum[qg] += __shfl_xor(lsum[qg], 16); lsum[qg] += __shfl_xor(lsum[qg], 32); }
    const float cmy = mp == 0 ? 1.f : -lam;
    const float sc0 = cmy / lsum[0], sc1 = cmy / lsum[1];
    LAS f32x4* xch = (LAS f32x4*)lds;
#pragma unroll
    for (int D = 0; D < 8; ++D) { const f32x4 give = mp == 0 ? O[1][D] * sc1 : O[0][D] * sc0; xch[(w * 8 + D) * 64 + lane] = give; }
    __syncthreads();
    float ss = 0.f;
#pragma unroll
    for (int D = 0; D < 8; ++D) { const f32x4 got = xch[((w ^ 1) * 8 + D) * 64 + lane]; const f32x4 mine = mp == 0 ? O[0][D] * sc0 : O[1][D] * sc1;
        O[0][D] = mine + got;
#pragma unroll
        for (int i = 0; i < 4; ++i) ss += O[0][D][i] * O[0][D][i]; }
    ss += __shfl_xor(ss, 16); ss += __shfl_xor(ss, 32);
    const float rinv = rsqrtf(ss * (1.f / 128.f) + EPS) * (1.f - lam_init);
    bf16_t* bz = (bf16_t*)(p.ws + WS_BZ) + ((size_t)(b * TB + q0 + 32 * pr + 16 * mp + fr)) * 1024 + h * 128;
    const float* sw = p.in[16] + l * 128;
#pragma unroll
    for (int D = 0; D < 8; ++D) { const int dv = 16 * D + 4 * fg;
        const u32x2 z = *(const u32x2*)(bz + dv); const f32x4 wv = *(const f32x4*)(sw + dv);
        const float y0 = O[0][D][0] * rinv * wv[0] * bf_lo(z[0]), y1 = O[0][D][1] * rinv * wv[1] * bf_hi(z[0]);
        const float y2 = O[0][D][2] * rinv * wv[2] * bf_lo(z[1]), y3 = O[0][D][3] * rinv * wv[3] * bf_hi(z[1]);
        u32x2 o; o[0] = cvtpk(y0, y1); o[1] = cvtpk(y2, y3); *(u32x2*)(bz + dv) = o; }
    __syncthreads();
}
__device__ __forceinline__ void attn_item(const Params& p, LAS unsigned char* lds, int l, int b, int h, int q0, int nkt) {
    const int lane = tid_opaque() & 63;
    const float mbw = 8.f * wave_max(fabsf(p.in[10][l * 64 + lane])) * wave_max(fabsf(p.in[11][l * 64 + lane])) * LOG2E;
    if (__builtin_amdgcn_readfirstlane(mbw < 64.f ? 1 : 0)) attn_body<false>(p, lds, l, b, h, q0, nkt);
    else attn_body<true>(p, lds, l, b, h, q0, nkt);
}

__device__ __forceinline__ void mlstm_item(const Params& p, LAS unsigned char* lds, int item) {
    const int tid = tid_opaque(), w = tid >> 6, lane = tid & 63, fr = lane & 15, fg = lane >> 4;
    const int sl = item & 1, dir = (item >> 1) & 1, h = (item >> 2) & 3, b = item >> 4;
    constexpr int S272 = 272, S144 = 144;
    constexpr int OQ = 0, OK_ = 17408, OKT = 34816, OVT = 53248, OA = 71680, OCT = 80896, OVEC = 115712;
    LAS unsigned char* QS = lds + OQ; LAS unsigned char* KS = lds + OK_; LAS unsigned char* KT = lds + OKT;
    LAS unsigned char* VT = lds + OVT; LAS unsigned char* AS = lds + OA; LAS unsigned char* CT = lds + OCT;
    LAS float* ve = (LAS float*)(lds + OVEC);
    LAS float* vM = ve + 64;
    LAS float* vwi = ve + 128;
    LAS float* vwk = ve + 192;
    LAS float* vemr = ve + 256;
    LAS float* vden = ve + 320;
    LAS float* vn = ve + 384;
    LAS float* vsc = ve + 640;
    const bf16_t* AQ = (const bf16_t*)(p.ws + WS_AQ) + (size_t)b * TB * 512 + h * 128;
    const bf16_t* AK = (const bf16_t*)(p.ws + WS_AK) + (size_t)b * TB * 512 + h * 128;
    const bf16_t* AVT = (const bf16_t*)(p.ws + WS_AVT) + ((size_t)b * 1024 + h * 256 + sl * 128) * TB;
    const float* GT = (const float*)(p.ws + WS_GATES) + (size_t)b * TB * 16 + (dir * 2) * 4 + h;
    bf16_t* HO = (bf16_t*)(p.ws + (dir ? WS_HB : WS_HF)) + (size_t)b * TB * 1024 + h * 256 + sl * 128;
    for (int i = tid; i < 128 * S272 / 4; i += 512) ((LAS unsigned*)CT)[i] = 0u;
    if (tid < 256) vn[tid] = 0.f;
    f32x4 cst[8];
#pragma unroll
    for (int i = 0; i < 8; ++i) cst[i] = (f32x4){0.f, 0.f, 0.f, 0.f};
    float m_st = 0.f;
    const int qr0 = tid >> 4, qcc = tid & 15;
    const int tr0 = tid >> 3, tcc = tid & 7;
    auto chunk_tb0 = [&](int c) -> int { return dir == 0 ? 64 * c : (c < 4 ? 256 - 64 * (c + 1) : 4352 - 64 * (c - 3)); };
    u32x4 gq0, gq1, gk0, gk1, gv0, gv1; float gig = 0.f, glf = 0.f;
    auto issue = [&](int c) {
        const int tb0 = chunk_tb0(c);
        gq0 = *(const u32x4*)(AQ + (size_t)(tb0 + qr0) * 512 + qcc * 8); gq1 = *(const u32x4*)(AQ + (size_t)(tb0 + qr0 + 32) * 512 + qcc * 8);
        gk0 = *(const u32x4*)(AK + (size_t)(tb0 + qr0) * 512 + qcc * 8); gk1 = *(const u32x4*)(AK + (size_t)(tb0 + qr0 + 32) * 512 + qcc * 8);
        gv0 = *(const u32x4*)(AVT + (size_t)tr0 * TB + tb0 + tcc * 8); gv1 = *(const u32x4*)(AVT + (size_t)(tr0 + 64) * TB + tb0 + tcc * 8);
        if (w == 0) { gig = GT[(size_t)(tb0 + lane) * 16]; glf = GT[(size_t)(tb0 + lane) * 16 + 4]; }
    };
    auto commit = [&]() {
        *(LAS u32x4*)(QS + qr0 * S272 + qcc * 16) = gq0; *(LAS u32x4*)(QS + (qr0 + 32) * S272 + qcc * 16) = gq1;
        *(LAS u32x4*)(KS + qr0 * S272 + qcc * 16) = gk0; *(LAS u32x4*)(KS + (qr0 + 32) * S272 + qcc * 16) = gk1;
        *(LAS u32x4*)(VT + tr0 * S144 + tcc * 16) = gv0; *(LAS u32x4*)(VT + (tr0 + 64) * S144 + tcc * 16) = gv1;
    };
    issue(0); commit();
    float ig_c = gig, lf_c = glf;
    __syncthreads();
    for (int c = 0; c < 68; ++c) {
        const int tb0 = chunk_tb0(c);
        const int np = c & 1;
        if (c + 1 < 68) issue(c + 1);
        if (w == 0) {
            float bcum = lf_c, e;
            if (dir == 0) {
#pragma unroll
                for (int o = 1; o < 64; o <<= 1) { const float t = __shfl_up(bcum, o); if (lane >= o) bcum += t; }
            } else {
#pragma unroll
                for (int o = 1; o < 64; o <<= 1) { const float t = __shfl_down(bcum, o); if (lane + o < 64) bcum += t; }
            }
            e = ig_c - bcum;
            float cm = e;
            if (dir == 0) {
#pragma unroll
                for (int o = 1; o < 64; o <<= 1) { const float t = __shfl_up(cm, o); if (lane >= o) cm = fmaxf(cm, t); }
            } else {
#pragma unroll
                for (int o = 1; o < 64; o <<= 1) { const float t = __shfl_down(cm, o); if (lane + o < 64) cm = fmaxf(cm, t); }
            }
            const int lastl = dir == 0 ? 63 : 0;
            const float btot = __shfl(bcum, lastl), emax = __shfl(cm, lastl);
            const float Mv = fmaxf(cm, m_st);
            const float E = fmaxf(m_st, emax);
            ve[lane] = e; vM[lane] = Mv; vwi[lane] = __expf(m_st - Mv); vemr[lane] = __expf(-(bcum + Mv)); vwk[lane] = __expf(e - E);
            if (lane == 0) vsc[0] = __expf(m_st - E);
            m_st = btot + E;
            ig_c = gig; lf_c = glf;
        }
        f32x4 st[2];
        { const int sm = w >> 1, tn0 = 2 * (w & 1);
          st[0] = (f32x4){0.f, 0.f, 0.f, 0.f}; st[1] = st[0];
#pragma unroll
          for (int ks = 0; ks < 4; ++ks) { const bf16x8 af = *(const LAS bf16x8*)(KS + (16 * sm + fr) * S272 + ks * 64 + fg * 16);
#pragma unroll
              for (int j = 0; j < 2; ++j) { const bf16x8 bfr = *(const LAS bf16x8*)(QS + (16 * (tn0 + j) + fr) * S272 + ks * 64 + fg * 16); st[j] = MFMA16(af, bfr, st[j]); } } }
        __syncthreads();
        { const int sm = w >> 1, tn0 = 2 * (w & 1);
#pragma unroll
          for (int j = 0; j < 2; ++j) { const int t = 16 * (tn0 + j) + fr; const float Mt = vM[t]; float v[4];
#pragma unroll
              for (int i = 0; i < 4; ++i) { const int s = 16 * sm + 4 * fg + i; const bool ok = dir == 0 ? (s <= t) : (s >= t);
                  const float f = __expf(ve[s] - Mt); v[i] = ok ? st[j][i] * f : 0.f; }
              u32x2 o; o[0] = cvtpk(v[0], v[1]); o[1] = cvtpk(v[2], v[3]);
              *(LAS u32x2*)(AS + t * S144 + (16 * sm + 4 * fg) * 2) = o; } }
        { const int dk = tid >> 2, seg = tid & 3; LAS unsigned char* rowp = KT + dk * S144 + seg * 32;
          u32x4 a, bb; float sum = 0.f;
#pragma unroll
          for (int q = 0; q < 4; ++q) { const int s = seg * 16 + 2 * q;
              const float x0 = __uint_as_float((unsigned)(*(const LAS unsigned short*)(KS + s * S272 + dk * 2)) << 16) * vwk[s];
              const float x1 = __uint_as_float((unsigned)(*(const LAS unsigned short*)(KS + (s + 1) * S272 + dk * 2)) << 16) * vwk[s + 1];
              a[q] = cvtpk(x0, x1); sum += bf_lo(a[q]) + bf_hi(a[q]); }
#pragma unroll
          for (int q = 0; q < 4; ++q) { const int s = seg * 16 + 8 + 2 * q;
              const float x0 = __uint_as_float((unsigned)(*(const LAS unsigned short*)(KS + s * S272 + dk * 2)) << 16) * vwk[s];
              const float x1 = __uint_as_float((unsigned)(*(const LAS unsigned short*)(KS + (s + 1) * S272 + dk * 2)) << 16) * vwk[s + 1];
              bb[q] = cvtpk(x0, x1); sum += bf_lo(bb[q]) + bf_hi(bb[q]); }
          *(LAS u32x4*)rowp = a; *(LAS u32x4*)(rowp + 16) = bb;
          sum += __shfl_xor(sum, 1); sum += __shfl_xor(sum, 2);
          if (seg == 0) vn[(np ^ 1) * 128 + dk] = vsc[0] * vn[np * 128 + dk] + sum; }
        __syncthreads();
        { const int t = tid >> 3, part = tid & 7;
          const u32x4 a = *(const LAS u32x4*)(AS + t * S144 + part * 16);
          float ds = 0.f;
#pragma unroll
          for (int q = 0; q < 4; ++q) ds += bf_lo(a[q]) + bf_hi(a[q]);
          const u32x4 q0 = *(const LAS u32x4*)(QS + t * S272 + part * 32), q1 = *(const LAS u32x4*)(QS + t * S272 + part * 32 + 16);
          const LAS float* nn = vn + np * 128 + part * 16; float qn = 0.f;
#pragma unroll
          for (int q = 0; q < 4; ++q) { qn += bf_lo(q0[q]) * nn[2 * q] + bf_hi(q0[q]) * nn[2 * q + 1]; qn += bf_lo(q1[q]) * nn[8 + 2 * q] + bf_hi(q1[q]) * nn[8 + 2 * q + 1]; }
          ds += __shfl_xor(ds, 1); ds += __shfl_xor(ds, 2); ds += __shfl_xor(ds, 4);
          qn += __shfl_xor(qn, 1); qn += __shfl_xor(qn, 2); qn += __shfl_xor(qn, 4);
          if (part == 0) vden[t] = ds + vwi[t] * qn; }
        f32x4 n1[4], n2[4];
        {
#pragma unroll
          for (int j = 0; j < 4; ++j) { n1[j] = (f32x4){0.f, 0.f, 0.f, 0.f}; n2[j] = n1[j]; }
#pragma unroll
          for (int ks = 0; ks < 2; ++ks) { const bf16x8 af = *(const LAS bf16x8*)(VT + (16 * w + fr) * S144 + ks * 64 + fg * 16);
#pragma unroll
              for (int j = 0; j < 4; ++j) { const bf16x8 bfr = *(const LAS bf16x8*)(AS + (16 * j + fr) * S144 + ks * 64 + fg * 16); n1[j] = MFMA16(af, bfr, n1[j]); } }
#pragma unroll
          for (int ks = 0; ks < 4; ++ks) { const bf16x8 af = *(const LAS bf16x8*)(CT + (16 * w + fr) * S272 + ks * 64 + fg * 16);
#pragma unroll
              for (int j = 0; j < 4; ++j) { const bf16x8 bfr = *(const LAS bf16x8*)(QS + (16 * j + fr) * S272 + ks * 64 + fg * 16); n2[j] = MFMA16(af, bfr, n2[j]); } } }
        { const float decay = vsc[0];
#pragma unroll
          for (int dn = 0; dn < 8; ++dn) cst[dn] *= decay;
#pragma unroll
          for (int ks = 0; ks < 2; ++ks) { const bf16x8 af = *(const LAS bf16x8*)(KT + (16 * w + fr) * S144 + ks * 64 + fg * 16);
#pragma unroll
              for (int dn = 0; dn < 8; ++dn) { const bf16x8 bfr = *(const LAS bf16x8*)(VT + (16 * dn + fr) * S144 + ks * 64 + fg * 16); cst[dn] = MFMA16(af, bfr, cst[dn]); } } }
        __syncthreads();
        {
#pragma unroll
          for (int j = 0; j < 4; ++j) { const int t = 16 * j + fr; const float wi = vwi[t]; const float dinv = 1.f / fmaxf(fabsf(vden[t]), vemr[t]);
              const float h0 = (n1[j][0] + wi * n2[j][0]) * dinv, h1 = (n1[j][1] + wi * n2[j][1]) * dinv, h2 = (n1[j][2] + wi * n2[j][2]) * dinv, h3 = (n1[j][3] + wi * n2[j][3]) * dinv;
              u32x2 o; o[0] = cvtpk(h0, h1); o[1] = cvtpk(h2, h3);
              __hip_atomic_store((unsigned long long*)(HO + (size_t)(tb0 + t) * 1024 + 16 * w + 4 * fg), ((unsigned long long)o[1] << 32) | o[0], __ATOMIC_RELAXED, __HIP_MEMORY_SCOPE_AGENT); } }
#pragma unroll
        for (int dn = 0; dn < 8; ++dn) { u32x2 o; o[0] = cvtpk(cst[dn][0], cst[dn][1]); o[1] = cvtpk(cst[dn][2], cst[dn][3]);
            *(LAS u32x2*)(CT + (16 * dn + fr) * S272 + (16 * w + 4 * fg) * 2) = o; }
        if (c + 1 < 68) commit();
        __syncthreads();
    }
}

__device__ __forceinline__ void mlstm_out_rows(const Params& p, int l, int r0, int nrows) {
    const int tid = tid_opaque(), lane = tid & 63, w = tid >> 6;
    const float* anw = p.in[9] + (size_t)l * 1024 + lane * 16;
    float wv[16];
#pragma unroll
    for (int j = 0; j < 16; ++j) wv[j] = anw[j];
    for (int r = r0 + w; r < r0 + nrows; r += 8) {
        const size_t o = (size_t)r * 1024 + lane * 16;
        const bf16_t* hf = (const bf16_t*)(p.ws + WS_HF) + o; const bf16_t* hb = (const bf16_t*)(p.ws + WS_HB) + o;
        bf16_t* ao = (bf16_t*)(p.ws + WS_AO) + o; const bf16_t* az = (const bf16_t*)(p.ws + WS_AZ) + o;
        float v[16]; float ss = 0.f;
#pragma unroll
        for (int hh = 0; hh < 2; ++hh) { const u32x4 a = *(const u32x4*)(hf + 8 * hh), bb = *(const u32x4*)(hb + 8 * hh);
#pragma unroll
            for (int q = 0; q < 4; ++q) { v[8 * hh + 2 * q] = bf_lo(a[q]) + bf_lo(bb[q]); v[8 * hh + 2 * q + 1] = bf_hi(a[q]) + bf_hi(bb[q]); } }
#pragma unroll
        for (int j = 0; j < 16; ++j) ss += v[j] * v[j];
        ss += __shfl_xor(ss, 1); ss += __shfl_xor(ss, 2); ss += __shfl_xor(ss, 4); ss += __shfl_xor(ss, 8);
        const float rinv = rsqrtf(ss * (1.f / 256.f) + EPS);
#pragma unroll
        for (int hh = 0; hh < 2; ++hh) { const u32x4 a = *(const u32x4*)(ao + 8 * hh), z = *(const u32x4*)(az + 8 * hh); u32x4 oo;
#pragma unroll
            for (int q = 0; q < 4; ++q) { const int j = 8 * hh + 2 * q;
                const float y0 = (v[j] * rinv) * wv[j] * bf_lo(a[q]) * bf_lo(z[q]);
                const float y1 = (v[j + 1] * rinv) * wv[j + 1] * bf_hi(a[q]) * bf_hi(z[q]);
                oo[q] = cvtpk(y0, y1); }
            *(u32x4*)(ao + 8 * hh) = oo; }
    }
}

extern __shared__ __attribute__((aligned(16))) unsigned char dyn_lds[];

__global__ void __launch_bounds__(NTHREADS) mega_fwd(const Params p0) {
    typedef const Params __attribute__((address_space(4))) * KP;
    KP kp = (KP)__builtin_amdgcn_kernarg_segment_ptr();
#define P (*(const Params*)kp)
#define LAUNDER() do { KP _k = (KP)__builtin_amdgcn_kernarg_segment_ptr(); asm volatile("" : "+s"(_k)); kp = _k; } while (0)
    cg::grid_group grid = cg::this_grid();
    LAS unsigned char* lds = (LAS unsigned char*)dyn_lds;
    volatile LAS unsigned* st = (volatile LAS unsigned*)(lds + LDS_BYTES - 16);
    if (threadIdx.x == 0) { st[0] = 0u; st[1] = 0u; st[2] = 0u; st[3] = 0u; }
    __syncthreads();
    unsigned* ctl = (unsigned*)(P.ws + WS_CTL);
    XcdBarrier xb = xcd_barrier_post(ctl, st);
    const int G = gridDim.x, bid = blockIdx.x, tid = threadIdx.x;

    phase0(P, lds);
    grid.sync();

#pragma unroll 1
    for (int l = 0; l < DEPTH; ++l) {
        const bool last = (l == DEPTH - 1);
        LAUNDER();
        phase_prenorm(P, lds, l);
        LAUNDER();
        if (l > 0) { for (int item = bid; item < N_CONV_ITEMS; item += G) convert_item(P, lds, l, item); }
        xcd_barrier(xb);
        LAUNDER();
        { SchedIn S{(const char*)(P.ws + WS_H), (const char*)(P.ws + WS_WNAT), (const char*)(P.ws + WS_WTR), G, bid}; EpiIn E{P.ws};
          gemm_phase<true, true>(lds, 1024, 2048u, 2048u, S, E); }
        xcd_barrier(xb);
        LAUNDER();
        phase_qkprep(P, lds, l);
        LAUNDER();
        { SchedF1L S{(const char*)(P.ws + WS_T2A), (const char*)(P.ws + WS_CU), G, bid}; EpiF1L E{P.ws};
          gemm_phase(lds, 256, 512u, 2048u, S, E); }
        LAUNDER();
        { SchedF1C S{(const char*)(P.ws + WS_T2A), (const char*)(P.ws + WS_CU), G, G - 1 - bid}; EpiF1C E{P.ws};
          gemm_phase(lds, 256, 512u, 2048u, S, E); }
        xcd_barrier(xb);
        LAUNDER();
        {
            { SchedFA S{(const char*)(P.ws + WS_ZTL), (const char*)(P.ws + WS_F2T), G, bid}; EpiFA E{P.ws};
              gemm_phase<true, false>(lds, 128, 256u, 256u, S, E); }
            unsigned* cb = ctl + 12288 + 1024 * l;
            unsigned* fa_done = cb; unsigned* ml_done = cb + 64; unsigned* ctxf_done = cb + 128; unsigned* ctxa_done = cb + 192; unsigned* ctxo_done = cb + 256; unsigned* ctxm_done = cb + 320;
            publish_add_wt(fa_done);
            LAUNDER();
            unsigned* counter = ctl + 4096 + 64 * l;
            const int nc = last ? 0 : 1;
            const int e0 = 64, e1 = e0 + 16 * nc, e2 = e1 + 64 * nc, e3 = e2 + 640, e4 = e3 + 16 * nc, e5 = e4 + 16 * nc, e6 = e5 + 16 * nc, e7 = e6 + 384, e8 = e7 + 256, e9 = e8 + 256;
            for (;;) {
                __syncthreads();
                if (tid == 0) st[2] = atomicAdd(counter, 1u);
                __syncthreads();
                const int item = (int)st[2];
                LAUNDER();
                if (item >= e9) break;
                if (item < e0) { mlstm_item(P, lds, item); publish_add_wt(ml_done); continue; }
                if (item < e1) { const int it = item - e0, pn = it & 3, b = it >> 2;
                    SchedOne S; S.u0.pm = 0; S.u0.pn = pn; S.u0.aux = b * TB;
                    S.u0.a = (const char*)(P.ws + WS_T2B); S.u0.b = (const char*)(P.ws + WS_ZTC) + ((size_t)b * 1024 + pn * 256) * 1024;
                    EpiF2 E{P.ws, 1.f / 256.f};
                    gemm_phase(lds, 512, 1024u, 1024u, S, E); publish_add(ctxf_done); continue; }
                if (item < e2) { const int it = item - e1, qb = it & 1, h = (it >> 1) & 7, b = it >> 4; attn_item(P, lds, l, b, h, 128 * qb, 2); publish_add(ctxa_done); continue; }
                if (item < e3 || (item >= e6 && item < e7)) { const int it = item < e3 ? item - e2 : 640 + (item - e6); const int qb = it & 31, h = (it >> 5) & 7, b = it >> 8;
                    attn_item(P, lds, l, b, h, 256 + 128 * qb, 34); continue; }
                if (item < e4) { const int it = item - e3; wait_count(ml_done, 64u); mlstm_out_rows(P, l, (it >> 2) * TB + 64 * (it & 3), 64); publish_add(ctxo_done); continue; }
                if (item < e5) { const int it = item - e4, pn = it & 3, b = it >> 2;
                    wait_count(ctxf_done, 16u); wait_count(ctxa_done, 64u); wait_count(ctxo_done, 16u);
                    SchedM1Cq S{(const char*)P.ws, 17 * b, pn}; EpiM1C E{P.ws};
                    gemm_phase<true, true>(lds, 1024, 2048u, 2048u, S, E); publish_add(ctxm_done + 64 * b); continue; }
                if (item < e6) { const int it = item - e5, pn = it & 3, b = it >> 2;
                    wait_count(ctxm_done + 64 * b, 4u);
                    SchedOne S; S.u0.pm = 17 * b; S.u0.pn = pn; S.u0.aux = 0;
                    S.u0.a = (const char*)(P.ws + WS_H) + (size_t)(17 * b) * 256 * 2048; S.u0.b = (const char*)(P.ws + WS_WOUT + 3 * 2097152) + (size_t)pn * 256 * 2048;
                    EpiM2 E{l == 0 ? P.in[0] : P.out, l == 0 ? P.in[2] : (const float*)(P.ws + WS_CTXS), P.out, (float*)(P.ws + WS_CTXS), (const float*)(P.ws + WS_MOD) + (size_t)l * 5 * 3072};
                    gemm_phase(lds, 1024, 2048u, 2048u, S, E); continue; }
                if (item < e8) { const int it = item - e7;
                    wait_count(ml_done, 64u); mlstm_out_rows(P, l, (it >> 6) * TB + 256 + 64 * (it & 63), 64); continue; }
                { const int it = item - e8; wait_count(fa_done, (unsigned)G);
                  SchedFB S{(const char*)(P.ws + WS_G2T), (const char*)(P.ws + WS_T1), 4 * it}; EpiFB E{P.ws};
                  gemm_phase<true, false>(lds, 128, 256u, 256u, S, E); }
            }
        }
        xcd_barrier(xb);
        LAUNDER();
        { SchedM1C S{(const char*)P.ws, G, bid, 1}; EpiM1C E{P.ws}; gemm_phase<true, true>(lds, 1024, 2048u, 2048u, S, E); }
        xcd_barrier(xb);
        LAUNDER();
        { SchedM S{(const char*)(P.ws + WS_H), (const char*)(P.ws + WS_WOUT + 3 * 2097152), G, bid, 1};
          EpiM2 E{l == 0 ? P.in[0] : P.out, l == 0 ? P.in[2] : (const float*)(P.ws + WS_CTXS), P.out, (float*)(P.ws + WS_CTXS), (const float*)(P.ws + WS_MOD) + (size_t)l * 5 * 3072};
          gemm_phase(lds, 1024, 2048u, 2048u, S, E); }
        if (!last) xcd_barrier(xb);
    }
}

extern "C" void kernel_launch(void* const* d_in, const int* in_sizes, int n_in, void* d_out, int out_size,
                              void* d_ws, size_t ws_size, hipStream_t stream) {
    static int grid_blocks = 0;
    if (!grid_blocks) {
        int dev = 0, cus = 0, per_cu = 0;
        (void)hipGetDevice(&dev);
        (void)hipDeviceGetAttribute(&cus, hipDeviceAttributeMultiprocessorCount, dev);
        (void)hipFuncSetAttribute((const void*)mega_fwd, hipFuncAttributeMaxDynamicSharedMemorySize, LDS_BYTES);
        (void)hipOccupancyMaxActiveBlocksPerMultiprocessor(&per_cu, (const void*)mega_fwd, NTHREADS, LDS_BYTES);
        grid_blocks = cus;
        if (ws_size < WS_END || per_cu < 1) fprintf(stderr, "kernel_launch: ws %zu (need %zu), per_cu %d\n", ws_size, (size_t)WS_END, per_cu);
    }
    (void)hipMemsetAsync(d_ws, 0, 65536, stream);
    Params p{};
    for (int i = 0; i < 21 && i < n_in; ++i) p.in[i] = (const float*)d_in[i];
    p.out = (float*)d_out; p.ws = (unsigned char*)d_ws;
    void* args[] = {&p};
    hipError_t e = hipLaunchCooperativeKernel((const void*)mega_fwd, dim3(grid_blocks), dim3(NTHREADS), args, LDS_BYTES, stream);
    if (e != hipSuccess) fprintf(stderr, "cooperative launch failed: %s (grid %d)\n", hipGetErrorString(e), grid_blocks);
}
```
